# Optimizing an MI355X kernel written in HIP

```python
import math
import jax, jax.numpy as jnp
from jax import lax
import numpy as np

D_MODEL = 1024
BATCH = 2
SEQ = 8192
DEPTH = 2

RET_HEADS = 4
RET_DK = D_MODEL // RET_HEADS
RET_DV = 2 * RET_DK
RET_CHUNK = 128
RET_THETA = 10000.0
ATT_GROUPS = ((128, 1), (512, 4), (2048, 16))
ATT_HEADS_PER_GROUP = 4
ATT_HEADS = ATT_HEADS_PER_GROUP * len(ATT_GROUPS)
ATT_DH = 128
ATT_ROT_DIM = ATT_DH // 4
ATT_THETA = 500000.0
D_FF = ((8 * D_MODEL // 3 + 255) // 256) * 256
NORM_EPS = 1e-6

SPLIT_SIZES = (
    RET_HEADS * RET_DK,
    RET_HEADS * RET_DK,
    RET_HEADS * RET_DV,
    RET_HEADS * RET_DV,
    ATT_HEADS * ATT_DH,
    ATT_HEADS * ATT_DH,
    ATT_HEADS * ATT_DH,
    D_MODEL,
    D_MODEL,
)
D_IN = sum(SPLIT_SIZES)

kernel_name = "hybrid_retention_dilated_attn_block"


def rmsnorm(x, g):
    xf = x.astype(jnp.float32)
    y = xf * lax.rsqrt(jnp.mean(xf * xf, axis=-1, keepdims=True) + NORM_EPS)
    return (y * g.astype(jnp.float32)).astype(x.dtype)


def rotary(x, rot_dim, theta):
    s = x.shape[1]
    half = rot_dim // 2
    inv = theta ** (-jnp.arange(half, dtype=jnp.float32) / half)
    ang = jnp.arange(s, dtype=jnp.float32)[:, None] * inv[None, :]
    cos = jnp.cos(ang)[None, :, None, :]
    sin = jnp.sin(ang)[None, :, None, :]
    xr = x[..., :rot_dim].astype(jnp.float32)
    x1, x2 = xr[..., :half], xr[..., half:]
    rot = jnp.concatenate([x1 * cos - x2 * sin, x1 * sin + x2 * cos], axis=-1)
    return jnp.concatenate([rot.astype(x.dtype), x[..., rot_dim:]], axis=-1)


def retention_chunkwise(q, k, v):
    b, s, h, dk = q.shape
    dv = v.shape[-1]
    c = RET_CHUNK
    n = s // c
    lg = jnp.log(1.0 - 2.0 ** (-5.0 - jnp.arange(h, dtype=jnp.float32)))
    pos = jnp.arange(c, dtype=jnp.float32)
    rel = pos[:, None] - pos[None, :]
    dmask = jnp.where(rel[None] >= 0,
                      jnp.exp(jnp.maximum(rel, 0.0)[None] * lg[:, None, None]), 0.0)
    xi = jnp.exp((pos + 1.0)[None, :] * lg[:, None])
    zeta = jnp.exp((c - 1.0 - pos)[None, :] * lg[:, None])
    chunk_decay = jnp.exp(c * lg)[None, :, None, None]

    def chunks(t):
        return t.astype(jnp.float32).reshape(b, n, c, h, t.shape[-1]).transpose(0, 1, 3, 2, 4)

    qc, kc, vc = chunks(q), chunks(k), chunks(v)
    scores = jnp.einsum('bnhcd,bnhmd->bnhcm', qc, kc) * dmask[None, None]
    intra = jnp.einsum('bnhcm,bnhme->bnhce', scores, vc)

    def step(r, xs):
        qn, kn, vn = xs
        out = jnp.einsum('bhcd,bhde->bhce', qn * xi[None, :, :, None], r)
        r = chunk_decay * r + jnp.einsum('bhcd,bhce->bhde', kn * zeta[None, :, :, None], vn)
        return r, out

    r0 = jnp.zeros((b, h, dk, dv), jnp.float32)
    _, cross = lax.scan(step, r0, (qc.transpose(1, 0, 2, 3, 4),
                                   kc.transpose(1, 0, 2, 3, 4),
                                   vc.transpose(1, 0, 2, 3, 4)))
    y = intra + cross.transpose(1, 0, 2, 3, 4)
    return y.transpose(0, 1, 3, 2, 4).reshape(b, s, h, dv)


def dilated_window_attention(q, k, v, window, dilation):
    b, s, h, dh = q.shape
    r = dilation
    nblk = window // dilation
    unit = r * nblk
    s_pad = -(-s // unit) * unit
    pad = ((0, 0), (0, s_pad - s), (0, 0), (0, 0))
    L = s_pad // r
    nb = L // nblk

    def to_blocks(t):
        t = jnp.pad(t, pad).reshape(b, L, r, h, dh).transpose(0, 2, 3, 1, 4)
        return t.reshape(b, r, h, nb, nblk, dh)

    qb, kb, vb = to_blocks(q), to_blocks(k), to_blocks(v)
    prev = lambda t: jnp.pad(t, ((0, 0), (0, 0), (0, 0), (1, 0), (0, 0), (0, 0)))[:, :, :, :-1]
    kcat = jnp.concatenate([prev(kb), kb], axis=4)
    vcat = jnp.concatenate([prev(vb), vb], axis=4)
    scale = 1.0 / math.sqrt(dh)
    scores = jnp.einsum('brhncd,brhnmd->brhncm', qb, kcat).astype(jnp.float32) * scale
    ci = jnp.arange(nblk)[:, None]
    mi = jnp.arange(2 * nblk)[None, :]
    dist = ci + nblk - mi
    valid = (dist >= 0) & (dist <= nblk)
    first = (jnp.arange(nb) == 0)[:, None, None] & (mi < nblk)[None]
    valid = valid[None] & ~first
    scores = jnp.where(valid, scores, -1e30)
    lse = jax.nn.logsumexp(scores, axis=-1)
    p = jnp.exp(scores - lse[..., None])
    out = jnp.einsum('brhncm,brhnmd->brhncd', p, vcat.astype(jnp.float32))
    out = out.reshape(b, r, h, L, dh).transpose(0, 3, 1, 2, 4).reshape(b, s_pad, h, dh)[:, :s]
    lse = lse.reshape(b, r, h, L).transpose(0, 3, 1, 2).reshape(b, s_pad, h)[:, :s]
    return out, lse


def hybrid_mixer(h, w_in, w_ret_out, w_att_out, w_o):
    b, s, _ = h.shape
    proj = h @ w_in
    idx = list(np.cumsum(SPLIT_SIZES)[:-1])
    rq, rk, rv, rg, aq, ak, av, gr, ga = jnp.split(proj, idx, axis=-1)

    rq = rotary(rq.reshape(b, s, RET_HEADS, RET_DK), RET_DK, RET_THETA)
    rk = rotary(rk.reshape(b, s, RET_HEADS, RET_DK), RET_DK, RET_THETA) * (RET_DK ** -0.5)
    rv = rv.reshape(b, s, RET_HEADS, RET_DV)
    yr = retention_chunkwise(rq, rk, rv)
    mu = jnp.mean(yr, axis=-1, keepdims=True)
    var = jnp.mean(jnp.square(yr - mu), axis=-1, keepdims=True)
    yr = ((yr - mu) * lax.rsqrt(var + NORM_EPS)).reshape(b, s, RET_HEADS * RET_DV)
    y_ret = (jax.nn.silu(rg.astype(jnp.float32)) * yr).astype(h.dtype) @ w_ret_out

    aq = rotary(aq.reshape(b, s, ATT_HEADS, ATT_DH), ATT_ROT_DIM, ATT_THETA)
    ak = rotary(ak.reshape(b, s, ATT_HEADS, ATT_DH), ATT_ROT_DIM, ATT_THETA)
    av = av.reshape(b, s, ATT_HEADS, ATT_DH)
    outs, lses = [], []
    for gi, (window, dilation) in enumerate(ATT_GROUPS):
        sl = slice(gi * ATT_HEADS_PER_GROUP, (gi + 1) * ATT_HEADS_PER_GROUP)
        o, l = dilated_window_attention(aq[:, :, sl], ak[:, :, sl], av[:, :, sl], window, dilation)
        outs.append(o)
        lses.append(l)
    wts = jax.nn.softmax(jnp.stack(lses, axis=0), axis=0)
    ya = jnp.sum(wts[..., None] * jnp.stack(outs, axis=0), axis=0)
    y_att = ya.reshape(b, s, ATT_HEADS_PER_GROUP * ATT_DH).astype(h.dtype) @ w_att_out

    merged = jax.nn.sigmoid(gr) * y_ret + jax.nn.sigmoid(ga) * y_att
    return merged @ w_o


def swiglu(h, w_gate, w_up, w_down):
    return (jax.nn.silu(h @ w_gate) * (h @ w_up)) @ w_down


def setup_inputs(seed: int = 0) -> dict:
    key = jax.random.key(seed)
    ks = jax.random.split(key, 12)
    f32 = jnp.float32

    def w(k, fan_in, fan_out):
        return jax.random.normal(k, (DEPTH, fan_in, fan_out), f32) * (fan_in ** -0.5)

    def gain(k):
        return 1.0 + 0.05 * jax.random.normal(k, (DEPTH, D_MODEL), f32)

    return {
        "x": jax.random.normal(ks[0], (BATCH, SEQ, D_MODEL), f32),
        "w_in": w(ks[1], D_MODEL, D_IN),
        "w_ret_out": w(ks[2], RET_HEADS * RET_DV, D_MODEL),
        "w_att_out": w(ks[3], ATT_HEADS_PER_GROUP * ATT_DH, D_MODEL),
        "w_o": w(ks[4], D_MODEL, D_MODEL),
        "w_ffn_gate": w(ks[5], D_MODEL, D_FF),
        "w_ffn_up": w(ks[6], D_MODEL, D_FF),
        "w_ffn_down": w(ks[7], D_FF, D_MODEL),
        "g_pre_mix": gain(ks[8]),
        "g_post_mix": gain(ks[9]),
        "g_pre_ffn": gain(ks[10]),
        "g_post_ffn": gain(ks[11]),
    }


def reference(x, w_in, w_ret_out, w_att_out, w_o, w_ffn_gate, w_ffn_up, w_ffn_down,
              g_pre_mix, g_post_mix, g_pre_ffn, g_post_ffn):
    for l in range(DEPTH):
        h = rmsnorm(x, g_pre_mix[l])
        m = hybrid_mixer(h, w_in[l], w_ret_out[l], w_att_out[l], w_o[l])
        x = x + rmsnorm(m, g_post_mix[l])
        h = rmsnorm(x, g_pre_ffn[l])
        f = swiglu(h, w_ffn_gate[l], w_ffn_up[l], w_ffn_down[l])
        x = x + rmsnorm(f, g_post_ffn[l])
    return x
```

```cpp
#ifdef EMU
#include "emu.h"
#else
#include <hip/hip_runtime.h>
#endif
#include <cstdio>
#include <cstdint>
#include <cmath>

#ifndef CFG_BATCH
#define CFG_BATCH 2
#endif
#ifndef CFG_SEQ
#define CFG_SEQ 8192
#endif
#ifndef MK_N_LAUNCHES
#define MK_N_LAUNCHES 0
#endif

#ifdef EMU
#define PG8_LAS
#define GAS
#define LAS
#define ASM_WAIT(s) ((void)0)
#define OPAQUE_V(x) ((void)0)
#define GLDS16(gp, lp) emu_global_load_lds16((const void*)(gp), (void*)(lp))
#else
#define PG8_LAS __attribute__((address_space(3)))
#define GAS __attribute__((address_space(1)))
#define LAS __attribute__((address_space(3)))
#define ASM_WAIT(s) asm volatile(s ::: "memory")
#define OPAQUE_V(x) asm volatile("" : "+v"(x))
#define GLDS16(gp, lp) __builtin_amdgcn_global_load_lds((const unsigned*)(gp), (PG8_LAS unsigned*)(lp), 16, 0, 0)
#endif

constexpr int NWAVES = 8;
constexpr int BATCH = CFG_BATCH, SEQ = CFG_SEQ, D = 1024, M = BATCH * SEQ;
constexpr int DIN = 12800, NATT = 4608, NRET = 8192, DFF = 2816, DEPTH = 2;
constexpr int NSEG = SEQ / 1024;
constexpr int NRU = BATCH * 4 * 4 * NSEG;
constexpr int NBLK = SEQ / 128;
constexpr int NAU = BATCH * 12 * NBLK;
constexpr float NORM_EPS = 1e-6f;
static_assert(SEQ % 2048 == 0 && M % 256 == 0, "shape");

constexpr size_t MiB = 1u << 20;
constexpr size_t WS_CTL = 0, CTL_ZERO_BYTES = 1 * MiB;
constexpr size_t WS_WIN = 1 * MiB, WS_WM = 26 * MiB, WS_WO = 31 * MiB, WS_WGU = 33 * MiB, WS_WD = 44 * MiB;
constexpr size_t WS_TABR = 50 * MiB, WS_TABA = 58 * MiB, WS_LSE = 59 * MiB, WS_XN = 60 * MiB, WS_ACT = 92 * MiB;
constexpr size_t RB = (size_t)M * 2048;
constexpr size_t A_AQ = 0, A_AK = RB * 3 / 2, A_AV = RB * 3;
constexpr size_t A_RQ = 0, A_RK = RB, A_RV = 2 * RB, A_AR = 4 * RB, A_GR = RB * 13 / 2, A_GA = RB * 15 / 2, A_F = RB * 17 / 2;
constexpr size_t A_T = 0, A_MG = 2 * RB, A_M32 = 0, A_ACT = 3 * RB, A_F32 = 0;
constexpr size_t WS_END = WS_ACT + RB * 19 / 2;
static_assert(A_AV - A_AK == A_AK - A_AQ && WS_END <= 400 * MiB, "d_ws map");
static_assert((size_t)SEQ * 128 * 4 * 2 <= 8 * MiB && (size_t)3 * M * 4 * 4 <= MiB && (size_t)M * D * 2 <= 32 * MiB, "d_ws map");
constexpr int CW_TMO = 0, CW_CODE = 1, CW_BAR = 4096;

namespace pg8 {
typedef unsigned short bf16_t;
typedef short bf16x8 __attribute__((ext_vector_type(8)));
typedef float f32x4 __attribute__((ext_vector_type(4)));
typedef unsigned u32x4 __attribute__((ext_vector_type(4)));
constexpr int BM = 256, BK = 64, HALF = 128, HTB = HALF * BK * 2  , STAGE_BYTES = 8 * HTB, NXCD = 8, WGM = 8;

__host__ __device__ __forceinline__ int lds_byte(int r, int c) { const int st = (r >> 4) * 2 + (c >> 5), rr = r & 15, cc = c & 31, ob = rr * 64 + cc * 2; return st * 1024 + (ob ^ (((ob >> 9) & 1) << 5)); }
__host__ __device__ __forceinline__ void stage_rc(int b, int& R, int& C) { const int st = b / 1024, sb = b % 1024, swz = sb ^ (((sb >> 9) & 1) << 5); R = (st >> 1) * 16 + swz / 64; C = (st & 1) * 32 + (swz % 64) / 2; }
__host__ __device__ __forceinline__ int perm32(int rho) { const int n = rho >> 4, i = rho & 15; return 8 * (i >> 2) + 4 * n + (i & 3); }

struct Unit { int pm, pn; };
struct Gemm { const bf16_t* A; const bf16_t* Bt; int M, N, K, lda, ldb; };

struct StaticOrder {
    int nM, nN, nwg, G, c;
    __host__ __device__ void init(int M, int N, int G_, int c_) { nM = M / BM; nN = N / BM; nwg = nM * nN; G = G_; c = c_; }
    __host__ __device__ bool next(int i, Unit& u) const {
        const long L = (long)i * G + c; if (L >= nwg) return false;
        int wgid = (int)L; { const int q = nwg / NXCD, r = nwg % NXCD, xcd = wgid % NXCD, off = wgid / NXCD; wgid = (xcd < r ? xcd * (q + 1) : r * (q + 1) + (xcd - r) * q) + off; }
        const int nig = WGM * nN, gid = wgid / nig, fm = gid * WGM, gsz = (nM - fm) < WGM ? (nM - fm) : WGM;
        u.pm = fm + ((wgid % nig) % gsz); u.pn = (wgid % nig) / gsz; return true;
    }
    __device__ __forceinline__ void a_ready(const Unit&) const {}
    __device__ __forceinline__ void done(const Unit&) const {}
};

#ifdef EMU
__device__ __forceinline__ unsigned cvt_pk_bf16(float lo, float hi) { return (unsigned)emu::f2bf(lo) | ((unsigned)emu::f2bf(hi) << 16); }
#else
__device__ __forceinline__ unsigned cvt_pk_bf16(float lo, float hi) { unsigned r; asm volatile("v_cvt_pk_bf16_f32 %0, %1, %2" : "=v"(r) : "v"(lo), "v"(hi)); return r; }
#endif
__device__ __forceinline__ u32x4 pack8(const f32x4 v0, const f32x4 v1) { u32x4 w; w.x = cvt_pk_bf16(v0[0], v0[1]); w.y = cvt_pk_bf16(v0[2], v0[3]); w.z = cvt_pk_bf16(v1[0], v1[1]); w.w = cvt_pk_bf16(v1[2], v1[3]); return w; }
__device__ __forceinline__ float fast_sigmoid(float x) { return __builtin_amdgcn_rcpf(1.0f + __expf(-x)); }
__device__ __forceinline__ f32x4 sigmoid4(const f32x4 v) { return (f32x4){fast_sigmoid(v[0]), fast_sigmoid(v[1]), fast_sigmoid(v[2]), fast_sigmoid(v[3])}; }
__device__ __forceinline__ f32x4 silu4(const f32x4 v) { return v * sigmoid4(v); }
struct EpiAtt {
    static constexpr bool PERM = true, AFTER_DRAIN = false;
    bf16_t* AQ; size_t tstride; const float* tabA;
    __device__ __forceinline__ void operator()(const f32x4 (&acc)[2][2][4][2], const Unit& u, int wr, int wc, int fr, int fq) const {
        const int t = u.pn / 6, ct = u.pn - 6 * t;
        bf16_t* base = AQ + (size_t)t * tstride;
        const float sc = (t == 0) ? 0.08838834764831845f : 1.0f;
        const int row0 = u.pm * BM + wr * 64 + fr, col0 = ct * BM + wc * 32 + 8 * fq;
        const bool rot = (t < 2) && (wc == 0);
        const float* cosT = tabA; const float* sinT = tabA + (size_t)CFG_SEQ * 16;
#pragma unroll
        for (int ai = 0; ai < 2; ++ai)
#pragma unroll
            for (int m = 0; m < 4; ++m) {
                const int row = row0 + ai * HALF + m * 16; bf16_t* rowp = base + (size_t)row * 1536 + col0;
                f32x4 c0 = {1.f, 1.f, 1.f, 1.f}, c1 = c0, s0 = {0.f, 0.f, 0.f, 0.f}, s1 = s0;
                if (rot) { const int pos = row % CFG_SEQ; const float* cp = cosT + (size_t)pos * 16 + 8 * (fq & 1); const float* sp = sinT + (size_t)pos * 16 + 8 * (fq & 1);
                    c0 = *(const f32x4*)cp; c1 = *(const f32x4*)(cp + 4); s0 = *(const f32x4*)sp; s1 = *(const f32x4*)(sp + 4); }
#pragma unroll
                for (int bj = 0; bj < 2; ++bj) {
                    f32x4 v0 = acc[ai][bj][m][0], v1 = acc[ai][bj][m][1];
                    if (rot) {
                        f32x4 o0, o1;
#pragma unroll
                        for (int e = 0; e < 4; ++e) { o0[e] = __shfl_xor(v0[e], 32); o1[e] = __shfl_xor(v1[e], 32); }
                        if (fq < 2) { v0 = v0 * c0 - o0 * s0; v1 = v1 * c1 - o1 * s1; }
                        else        { v0 = o0 * s0 + v0 * c0; v1 = o1 * s1 + v1 * c1; }
                    }
                    v0 = v0 * sc; v1 = v1 * sc;
                    *(u32x4*)(rowp + bj * HALF) = pack8(v0, v1);
                }
            }
    }
};
struct EpiRet {
    static constexpr bool PERM = true, AFTER_DRAIN = false;
    bf16_t* act; const float* tabR;
    static constexpr size_t oRQ = A_RQ / 2, oRK = A_RK / 2, oRV = A_RV / 2, oAR = A_AR / 2, oGR = A_GR / 2, oGA = A_GA / 2;
    __device__ __forceinline__ void operator()(const f32x4 (&acc)[2][2][4][2], const Unit& u, int wr, int wc, int fr, int fq) const {
        const int pn = u.pn; const int row0 = u.pm * BM + wr * 64 + fr, cw = wc * 32 + 8 * fq;
        if (pn < 8) {
            bf16_t* base = act + (pn < 4 ? oRQ : oRK); const float sc = pn < 4 ? 1.0f : 0.0625f; const int colh = (pn & 3) * 256 + cw;
            const float* cosT = tabR; const float* sinT = tabR + (size_t)CFG_SEQ * 128;
#pragma unroll
            for (int ai = 0; ai < 2; ++ai)
#pragma unroll
                for (int m = 0; m < 4; ++m) {
                    const int row = row0 + ai * HALF + m * 16, pos = row % CFG_SEQ; bf16_t* rowp = base + (size_t)row * 1024 + colh;
                    const float* cp = cosT + (size_t)pos * 128 + cw; const float* sp = sinT + (size_t)pos * 128 + cw;
                    const f32x4 c0 = *(const f32x4*)cp, c1 = *(const f32x4*)(cp + 4), s0 = *(const f32x4*)sp, s1 = *(const f32x4*)(sp + 4);
                    const f32x4 a0 = acc[ai][0][m][0], a1 = acc[ai][0][m][1], b0 = acc[ai][1][m][0], b1 = acc[ai][1][m][1];
                    *(u32x4*)(rowp) = pack8((a0 * c0 - b0 * s0) * sc, (a1 * c1 - b1 * s1) * sc);
                    *(u32x4*)(rowp + HALF) = pack8((a0 * s0 + b0 * c0) * sc, (a1 * s1 + b1 * c1) * sc);
                }
        } else {
            size_t boff; int ldc, col; int mode;
            if (pn < 16)      { boff = oRV; ldc = 2048; col = (pn - 8) * 256; mode = 0; }
            else if (pn < 24) { boff = oAR; ldc = 2560; col = 512 + (pn - 16) * 256; mode = 1; }
            else if (pn < 28) { boff = oGR; ldc = 1024; col = (pn - 24) * 256; mode = 2; }
            else              { boff = oGA; ldc = 1024; col = (pn - 28) * 256; mode = 2; }
            bf16_t* base = act + boff;
#pragma unroll
            for (int ai = 0; ai < 2; ++ai)
#pragma unroll
                for (int m = 0; m < 4; ++m) {
                    bf16_t* rowp = base + (size_t)(row0 + ai * HALF + m * 16) * ldc + col + cw;
#pragma unroll
                    for (int bj = 0; bj < 2; ++bj) {
                        f32x4 v0 = acc[ai][bj][m][0], v1 = acc[ai][bj][m][1];
                        if (mode == 1) { v0 = silu4(v0); v1 = silu4(v1); } else if (mode == 2) { v0 = sigmoid4(v0); v1 = sigmoid4(v1); }
                        *(u32x4*)(rowp + bj * HALF) = pack8(v0, v1);
                    }
                }
        }
    }
};
struct EpiGate {
    static constexpr bool PERM = true, AFTER_DRAIN = false;
    float* O32; bf16_t* O16; int ldc; const bf16_t* gate; int ldg; const float* add; int lda_;
    __device__ __forceinline__ void operator()(const f32x4 (&acc)[2][2][4][2], const Unit& u, int wr, int wc, int fr, int fq) const {
        const int row0 = u.pm * BM + wr * 64 + fr, col0 = u.pn * BM + wc * 32 + 8 * fq;
#pragma unroll
        for (int ai = 0; ai < 2; ++ai)
#pragma unroll
            for (int m = 0; m < 4; ++m) {
                const size_t row = (size_t)(row0 + ai * HALF + m * 16);
#pragma unroll
                for (int bj = 0; bj < 2; ++bj) {
                    f32x4 v0 = acc[ai][bj][m][0], v1 = acc[ai][bj][m][1]; const int col = col0 + bj * HALF;
                    if (gate) { const u32x4 g = *(const u32x4*)(gate + row * ldg + col);
                        v0 = v0 * (f32x4){__uint_as_float(g.x << 16), __uint_as_float(g.x & 0xffff0000u), __uint_as_float(g.y << 16), __uint_as_float(g.y & 0xffff0000u)};
                        v1 = v1 * (f32x4){__uint_as_float(g.z << 16), __uint_as_float(g.z & 0xffff0000u), __uint_as_float(g.w << 16), __uint_as_float(g.w & 0xffff0000u)}; }
                    if (add) { v0 = v0 + *(const f32x4*)(add + row * lda_ + col); v1 = v1 + *(const f32x4*)(add + row * lda_ + col + 4); }
                    if (O32) { *(f32x4*)(O32 + row * ldc + col) = v0; *(f32x4*)(O32 + row * ldc + col + 4) = v1; }
                    if (O16) *(u32x4*)(O16 + row * ldc + col) = pack8(v0, v1);
                }
            }
    }
};
struct EpiSwiGLU {
    static constexpr bool PERM = true, AFTER_DRAIN = false;
    bf16_t* O; int ldc;
    __device__ __forceinline__ void operator()(const f32x4 (&acc)[2][2][4][2], const Unit& u, int wr, int wc, int fr, int fq) const {
        const int row0 = u.pm * BM + wr * 64 + fr, col0 = u.pn * HALF + wc * 32 + 8 * fq;
#pragma unroll
        for (int ai = 0; ai < 2; ++ai)
#pragma unroll
            for (int m = 0; m < 4; ++m) {
                const size_t row = (size_t)(row0 + ai * HALF + m * 16);
                const f32x4 v0 = silu4(acc[ai][0][m][0]) * acc[ai][1][m][0], v1 = silu4(acc[ai][0][m][1]) * acc[ai][1][m][1];
                *(u32x4*)(O + row * ldc + col0) = pack8(v0, v1);
            }
    }
};

template <class Epi, class Sched, bool ALIGN_EPI = false, bool SP2 = false>
__device__ __forceinline__ void gemm_phase(PG8_LAS unsigned char* lds, const Gemm g, const Sched& S, const Epi& E) {
    int tid_ = threadIdx.x; OPAQUE_V(tid_); const int tid = tid_, wid = __builtin_amdgcn_readfirstlane(tid >> 6), lane = tid & 63, wr = wid >> 2, wc = wid & 3, fr = lane & 15, fq = lane >> 4;
    const int K = g.K, nt = K / BK;
    unsigned voffA[2], voffB[2];
#pragma unroll
    for (int i = 0; i < 2; ++i) { int R, C; stage_rc(tid * 16 + i * 8192, R, C); const int Rb = Epi::PERM ? ((R & ~31) + perm32(R & 31)) : R;
        voffA[i] = (unsigned)(R * g.lda + C) * 2u; voffB[i] = (unsigned)(Rb * g.ldb + C) * 2u; }
    const size_t kstep = (size_t)(BK * 2);
    const size_t hstepA = (size_t)HALF * g.lda * 2, hstepB = (size_t)HALF * g.ldb * 2;
    const size_t tstepA = 2 * hstepA, tstepB = 2 * hstepB;
    const unsigned ldsw = (unsigned)wid * 1024u;
    const int aoff = lds_byte(wr * 64 + fr, fq * 8), boff = lds_byte(wc * 32 + fr, fq * 8);
#define PG8_SA(b, h) (((b) * 2 + (h)) * HTB)
#define PG8_SB(b, h) ((4 + (b) * 2 + (h)) * HTB)
#define PG8_STAGE(bufoff, gbase, voff) do { _Pragma("unroll") for (int _i = 0; _i < 2; ++_i) \
        GLDS16((const char*)(gbase) + (voff)[_i], lds + (bufoff) + ldsw + _i * 8192); } while (0)
#define PG8_LDA(dst, b, h) do { _Pragma("unroll") for (int m = 0; m < 4; ++m) _Pragma("unroll") for (int k = 0; k < 2; ++k) dst[m][k] = *(const PG8_LAS bf16x8*)(lds + PG8_SA(b, h) + aoff + m * 2048 + k * 1024); } while (0)
#define PG8_LDB(dst, b, h) do { _Pragma("unroll") for (int n = 0; n < 2; ++n) _Pragma("unroll") for (int k = 0; k < 2; ++k) dst[n][k] = *(const PG8_LAS bf16x8*)(lds + PG8_SB(b, h) + boff + n * 2048 + k * 1024); } while (0)
#define PG8_MMA(ai, bj, At, Bt) do { __builtin_amdgcn_s_setprio(1); _Pragma("unroll") for (int m = 0; m < 4; ++m) _Pragma("unroll") for (int n = 0; n < 2; ++n) _Pragma("unroll") for (int k = 0; k < 2; ++k) \
        acc[ai][bj][m][n] = __builtin_amdgcn_mfma_f32_16x16x32_bf16(Bt[n][k], At[m][k], acc[ai][bj][m][n], 0, 0, 0); __builtin_amdgcn_s_setprio(0); } while (0)
#define PG8_WAIT_V(n) ASM_WAIT("s_waitcnt vmcnt(" #n ")")
#define PG8_WAIT_L(n) ASM_WAIT("s_waitcnt lgkmcnt(" #n ")")
#define PG8_BAR __builtin_amdgcn_s_barrier()
#define PG8_SCHED __builtin_amdgcn_sched_barrier(0)
    Unit cur, nxt; int ui = 0;
    if (!S.next(0, cur)) return;
    f32x4 acc[2][2][4][2];
#pragma unroll
    for (int a = 0; a < 2; ++a)
#pragma unroll
        for (int b = 0; b < 2; ++b)
#pragma unroll
            for (int m = 0; m < 4; ++m)
#pragma unroll
                for (int n = 0; n < 2; ++n) acc[a][b][m][n] = (f32x4){0.f, 0.f, 0.f, 0.f};
    bf16x8 At[4][2], B0[2][2], B1[2][2];
    const char* cA = (const char*)g.A + (size_t)cur.pm * tstepA; const char* cB = (const char*)g.Bt + (size_t)cur.pn * tstepB;
    S.a_ready(cur);
    if constexpr (SP2) {
        PG8_STAGE(PG8_SB(0, 0), cB, voffB); PG8_STAGE(PG8_SB(0, 1), cB + hstepB, voffB); PG8_STAGE(PG8_SA(0, 0), cA, voffA); PG8_STAGE(PG8_SA(0, 1), cA + hstepA, voffA);
        if (wr == 1) PG8_BAR;
        PG8_WAIT_V(2); PG8_BAR;
        PG8_STAGE(PG8_SB(1, 0), cB + kstep, voffB); PG8_STAGE(PG8_SA(1, 0), cA + kstep, voffA); PG8_STAGE(PG8_SB(1, 1), cB + hstepB + kstep, voffB);
        PG8_WAIT_V(6); PG8_BAR;
    } else {
        PG8_STAGE(PG8_SB(0, 0), cB, voffB); PG8_STAGE(PG8_SA(0, 0), cA, voffA); PG8_STAGE(PG8_SB(0, 1), cB + hstepB, voffB); PG8_STAGE(PG8_SA(0, 1), cA + hstepA, voffA);
        if (wr == 1) PG8_BAR;
        PG8_WAIT_V(4); PG8_BAR;
        PG8_STAGE(PG8_SB(1, 0), cB + kstep, voffB); PG8_STAGE(PG8_SA(1, 0), cA + kstep, voffA); PG8_STAGE(PG8_SB(1, 1), cB + hstepB + kstep, voffB);
        PG8_WAIT_V(6); PG8_BAR;
    }
    for (;;) {
        const bool has_next = S.next(ui + 1, nxt);
        const char* nA = has_next ? (const char*)g.A + (size_t)nxt.pm * tstepA : cA; const char* nB = has_next ? (const char*)g.Bt + (size_t)nxt.pn * tstepB : cB;
        for (int t = 0; t < nt; t += 2) {
            const bool last = (t == nt - 2);
            const char* a1 = cA + (size_t)(t + 1) * kstep;
            const char* a2 = last ? nA : cA + (size_t)(t + 2) * kstep; const char* b2 = last ? nB : cB + (size_t)(t + 2) * kstep;
            const char* a3 = a2 + kstep; const char* b3 = b2 + kstep;
            if (last && has_next) S.a_ready(nxt);
            if constexpr (SP2) {
            PG8_LDB(B0, 0, 0); PG8_LDB(B1, 0, 1); PG8_SCHED; PG8_LDA(At, 0, 0); PG8_STAGE(PG8_SA(1, 1), a1 + hstepA, voffA);
            PG8_WAIT_V(8); PG8_WAIT_L(0); PG8_BAR; PG8_MMA(0, 0, At, B0); PG8_MMA(0, 1, At, B1); PG8_BAR; PG8_SCHED;
            PG8_LDA(At, 0, 1); PG8_STAGE(PG8_SB(0, 0), b2, voffB); PG8_STAGE(PG8_SB(0, 1), b2 + hstepB, voffB); PG8_STAGE(PG8_SA(0, 0), a2, voffA);
            PG8_WAIT_V(8); PG8_WAIT_L(0); PG8_BAR; PG8_MMA(1, 0, At, B0); PG8_MMA(1, 1, At, B1); PG8_BAR; PG8_SCHED;
            PG8_LDB(B0, 1, 0); PG8_LDB(B1, 1, 1); PG8_SCHED; PG8_LDA(At, 1, 0); PG8_STAGE(PG8_SA(0, 1), a2 + hstepA, voffA);
            PG8_WAIT_V(8); PG8_WAIT_L(0); PG8_BAR; PG8_MMA(0, 0, At, B0); PG8_MMA(0, 1, At, B1); PG8_BAR; PG8_SCHED;
            PG8_LDA(At, 1, 1); PG8_STAGE(PG8_SB(1, 0), b3, voffB); PG8_STAGE(PG8_SB(1, 1), b3 + hstepB, voffB); PG8_STAGE(PG8_SA(1, 0), a3, voffA);
            PG8_WAIT_V(8); PG8_WAIT_L(0); PG8_BAR; PG8_MMA(1, 0, At, B0); PG8_MMA(1, 1, At, B1); PG8_BAR; PG8_SCHED;
            } else {
            PG8_LDB(B0, 0, 0); PG8_SCHED; PG8_LDA(At, 0, 0); PG8_STAGE(PG8_SA(1, 1), a1 + hstepA, voffA);
            PG8_WAIT_L(8); PG8_BAR; PG8_WAIT_L(0); PG8_MMA(0, 0, At, B0); PG8_BAR; PG8_SCHED;
            PG8_LDB(B1, 0, 1); PG8_STAGE(PG8_SB(0, 0), b2, voffB);
            PG8_BAR; PG8_WAIT_L(0); PG8_MMA(0, 1, At, B1); PG8_BAR;
            PG8_LDA(At, 0, 1); PG8_STAGE(PG8_SA(0, 0), a2, voffA);
            PG8_BAR; PG8_WAIT_L(0); PG8_MMA(1, 0, At, B0); PG8_BAR; PG8_SCHED;
            PG8_STAGE(PG8_SB(0, 1), b2 + hstepB, voffB);
            PG8_WAIT_V(6); PG8_BAR; PG8_MMA(1, 1, At, B1); PG8_BAR;
            PG8_LDB(B0, 1, 0); PG8_SCHED; PG8_LDA(At, 1, 0); PG8_STAGE(PG8_SA(0, 1), a2 + hstepA, voffA);
            PG8_WAIT_L(8); PG8_BAR; PG8_WAIT_L(0); PG8_MMA(0, 0, At, B0); PG8_BAR; PG8_SCHED;
            PG8_LDB(B1, 1, 1); PG8_STAGE(PG8_SB(1, 0), b3, voffB);
            PG8_BAR; PG8_WAIT_L(0); PG8_MMA(0, 1, At, B1); PG8_BAR;
            PG8_LDA(At, 1, 1); PG8_STAGE(PG8_SA(1, 0), a3, voffA);
            PG8_BAR; PG8_WAIT_L(0); PG8_MMA(1, 0, At, B0); PG8_BAR; PG8_SCHED;
            PG8_STAGE(PG8_SB(1, 1), b3 + hstepB, voffB);
            PG8_WAIT_V(6); PG8_BAR; PG8_MMA(1, 1, At, B1); PG8_BAR;
            }
        }
        if constexpr (ALIGN_EPI) { if (wr == 0) PG8_BAR; }
        if constexpr (!Epi::AFTER_DRAIN) { E(acc, cur, wr, wc, fr, fq); S.done(cur); }
        if (!has_next) break;
#pragma unroll
        for (int a = 0; a < 2; ++a)
#pragma unroll
            for (int b = 0; b < 2; ++b)
#pragma unroll
                for (int m = 0; m < 4; ++m)
#pragma unroll
                    for (int n = 0; n < 2; ++n) acc[a][b][m][n] = (f32x4){0.f, 0.f, 0.f, 0.f};
        cur = nxt; cA = nA; cB = nB; ++ui;
        if constexpr (ALIGN_EPI) { if (wr == 1) PG8_BAR; }
    }
    PG8_WAIT_V(0);
    if constexpr (!ALIGN_EPI) { if (wr == 0) PG8_BAR; }
    PG8_BAR;
    if constexpr (Epi::AFTER_DRAIN) { E.fused(acc, cur, wr, wc, fr, fq, lds, wid, lane); S.done(cur); }
#undef PG8_SA
#undef PG8_SB
#undef PG8_STAGE
#undef PG8_LDA
#undef PG8_LDB
#undef PG8_MMA
#undef PG8_WAIT_V
#undef PG8_WAIT_L
#undef PG8_BAR
#undef PG8_SCHED
}
}
constexpr int RING_OFF = 0, RING_BYTES = 143360;
constexpr int LDSCTL_OFF = RING_BYTES, MISC_OFF = LDSCTL_OFF + 320;
constexpr int LDS_BYTES = 147456;
static_assert(MISC_OFF + 128 <= LDS_BYTES && pg8::STAGE_BYTES <= RING_BYTES, "LDS map");

typedef unsigned short bf16;
typedef unsigned v4u __attribute__((ext_vector_type(4)));
typedef unsigned v2u __attribute__((ext_vector_type(2)));
typedef float f32x4 __attribute__((ext_vector_type(4)));
typedef GAS unsigned gu32;
#define RLX_AGENT __ATOMIC_RELAXED, __HIP_MEMORY_SCOPE_AGENT
#define LDS_WAIT() ASM_WAIT("s_waitcnt lgkmcnt(0)")
#define VM_WAIT() ASM_WAIT("s_waitcnt vmcnt(0)")
#ifdef EMU
#define WAVE_SYNC() do { int _z = 0; (void)__shfl_xor(_z, 0); } while (0)
#else
#define WAVE_SYNC() do { asm volatile("s_waitcnt lgkmcnt(0)" ::: "memory"); __builtin_amdgcn_wave_barrier(); } while (0)
#endif
__device__ __forceinline__ unsigned f2bf(float f) { unsigned u = __float_as_uint(f); return (u + 0x7fffu + ((u >> 16) & 1u)) >> 16; }
__device__ __forceinline__ unsigned pk2(float lo, float hi) { return f2bf(lo) | (f2bf(hi) << 16); }
__device__ __forceinline__ float bflo(unsigned w) { return __uint_as_float(w << 16); }
__device__ __forceinline__ float bfhi(unsigned w) { return __uint_as_float(w & 0xffff0000u); }
__device__ __forceinline__ float bf2f(bf16 h) { return __uint_as_float((unsigned)h << 16); }

#define XB_TMO      128
#define XB_XCNT(j)  (256  + 64 * (j))
#define XB_XSUB(j)  (1280 + 64 * (j))
#define XB_XGEN(j)  (2304 + 64 * (j))
#define XB_TOP      3328
#define XB_TOPGEN   3392
#define XCD_BAR_WORDS 3456
#define XB_SPIN_CAP (1u << 18)

__device__ __forceinline__ unsigned xb_ld(unsigned* p)              { return __hip_atomic_load(p, __ATOMIC_RELAXED, __HIP_MEMORY_SCOPE_AGENT); }
__device__ __forceinline__ unsigned xb_add(unsigned* p, unsigned v) { return __hip_atomic_fetch_add(p, v, __ATOMIC_RELAXED, __HIP_MEMORY_SCOPE_AGENT); }
__device__ __forceinline__ unsigned xb_xcc_id() { return (unsigned)__builtin_amdgcn_s_getreg((3 << 11) | 20) & 0xFu; }
#define XB_SPIN(cond, bar) do { unsigned _sp = 0; while (cond) { __builtin_amdgcn_s_sleep(1); \
    if ((++_sp & 255u) == 0u) { if (xb_ld(&(bar)[XB_TMO])) break; if (_sp > XB_SPIN_CAP) { atomicAdd(&(bar)[XB_TMO], 1u); break; } } } } while (0)

struct XcdBarrier {
    unsigned* bar; unsigned x;
    volatile LAS unsigned* st;
};

__device__ __forceinline__ XcdBarrier xcd_barrier_post(unsigned* bar, volatile LAS unsigned* st) {
    XcdBarrier b; b.bar = bar; b.x = xb_xcc_id(); b.st = st;
    if (threadIdx.x == 0) (void)xb_add(&bar[XB_XCNT(b.x)], 1u);
    return b;
}
__device__ __forceinline__ void xcd_barrier_complete(unsigned* bar, unsigned x, unsigned& nloc, unsigned& nx) {
    const unsigned G = gridDim.x * gridDim.y * gridDim.z;
    unsigned sum, cnt, mine, sp = 0u;
    for (;;) {
        sum = 0u; cnt = 0u; mine = 0u;
#pragma unroll
        for (unsigned j = 0; j < 16; ++j) { const unsigned c = xb_ld(&bar[XB_XCNT(j)]); sum += c; cnt += (c > 0u) ? 1u : 0u; mine = (j == x) ? c : mine; }
        if (sum == G) break;
        __builtin_amdgcn_s_sleep(1);
        if ((++sp & 255u) == 0u) { if (xb_ld(&bar[XB_TMO])) break; if (sp > XB_SPIN_CAP) { atomicAdd(&bar[XB_TMO], 1u); break; } }
    }
    nloc = mine > 0u ? mine : 1u; nx = cnt > 0u ? cnt : 1u;
}

__device__ __forceinline__ void xcd_barrier(const XcdBarrier& b) {
    VM_WAIT();
    __syncthreads();
    if (threadIdx.x == 0) {
        unsigned* bar = b.bar;
        __builtin_amdgcn_s_waitcnt(0);
        unsigned nloc = b.st[0], nx = b.st[1];
        if (nloc == 0u) { xcd_barrier_complete(bar, b.x, nloc, nx); b.st[0] = nloc; b.st[1] = nx; }
        const unsigned old = xb_add(&bar[XB_XSUB(b.x)], 1u);
        const unsigned gen = old / nloc;
        if (old + 1u == (gen + 1u) * nloc) {
            __builtin_amdgcn_fence(__ATOMIC_RELEASE, "agent");
            VM_WAIT();
            const unsigned og = xb_add(&bar[XB_TOP], 1u);
            const unsigned tg = og / nx;
            if (og + 1u == (tg + 1u) * nx) xb_add(&bar[XB_TOPGEN], 1u);
            else XB_SPIN(xb_ld(&bar[XB_TOPGEN]) == tg, bar);
            __builtin_amdgcn_fence(__ATOMIC_ACQUIRE, "agent");
            xb_add(&bar[XB_XGEN(b.x)], 1u);
            VM_WAIT();
        } else {
            XB_SPIN(xb_ld(&bar[XB_XGEN(b.x)]) == gen, bar);
            __builtin_amdgcn_fence(__ATOMIC_ACQUIRE, "agent");
            VM_WAIT();
        }
    }
    __syncthreads();
}

struct Frame {
    LAS unsigned char* lds;
    volatile LAS unsigned* MISC;
    gu32* ctl;
    unsigned char* ws;
    int tid, lane, wave;
    int vcu, G;
};
__device__ __forceinline__ float wave_sum(float v) {
#pragma unroll
    for (int o = 1; o < 64; o <<= 1) v += __shfl_xor(v, o);
    return v;
}
__device__ __forceinline__ float wave_max(float v) {
#pragma unroll
    for (int o = 1; o < 64; o <<= 1) v = fmaxf(v, __shfl_xor(v, o));
    return v;
}
__device__ __forceinline__ void p0_transpose_item(const float* W, int N, bf16* WT, int ldt, int drow0, int kdst0, int k0, int n0, LAS float* scr, int lane) {
#pragma unroll 8
    for (int i = 0; i < 32; ++i) { const int kk = 2 * i + (lane >> 5); scr[kk * 33 + (lane & 31)] = W[(size_t)(k0 + kk) * N + n0 + (lane & 31)]; }
    WAVE_SYNC();
    const int c = lane & 7;
#pragma unroll
    for (int j = 0; j < 4; ++j) { const int n = (lane >> 3) + 8 * j; const LAS float* s = scr + (8 * c) * 33 + n;
        v4u o; o.x = pk2(s[0 * 33], s[1 * 33]); o.y = pk2(s[2 * 33], s[3 * 33]); o.z = pk2(s[4 * 33], s[5 * 33]); o.w = pk2(s[6 * 33], s[7 * 33]);
        *(v4u*)(WT + (size_t)(drow0 + n) * ldt + kdst0 + k0 + 8 * c) = o; }
    WAVE_SYNC();
}
__device__ __forceinline__ void p0_weights(Frame& F, const float* const* in, int l) {
    LAS float* scr = (LAS float*)(F.lds + RING_OFF + F.wave * 16384);
    const int gw = F.vcu * NWAVES + F.wave, NGW = F.G * NWAVES;
    bf16* WinT = (bf16*)(F.ws + WS_WIN); bf16* WmT = (bf16*)(F.ws + WS_WM); bf16* WoT = (bf16*)(F.ws + WS_WO); bf16* WguT = (bf16*)(F.ws + WS_WGU); bf16* WdT = (bf16*)(F.ws + WS_WD);
    const float* w_in = in[1] + (size_t)l * D * DIN; const float* w_ro = in[2] + (size_t)l * 2048 * D; const float* w_ao = in[3] + (size_t)l * 512 * D;
    const float* w_o = in[4] + (size_t)l * D * D; const float* w_g = in[5] + (size_t)l * D * DFF; const float* w_u = in[6] + (size_t)l * D * DFF; const float* w_d = in[7] + (size_t)l * DFF * D;
    constexpr int I_IN = (D / 64) * (DIN / 32), I_AO = (512 / 64) * (D / 32), I_RO = (2048 / 64) * (D / 32), I_O = (D / 64) * (D / 32), I_G = (D / 64) * (DFF / 32), I_D = (DFF / 64) * (D / 32);
    constexpr int NITEMS = I_IN + I_AO + I_RO + I_O + 2 * I_G + I_D;
    for (int it = gw; it < NITEMS; it += NGW) {
        int r = it;
        if (r < I_IN) { const int nb = r % (DIN / 32), kb = r / (DIN / 32), n0 = nb * 32;
            const int drow0 = (n0 >= 6144 && n0 < 10752) ? n0 - 6144 : (n0 < 6144 ? n0 + 4608 : n0);
            p0_transpose_item(w_in, DIN, WinT, D, drow0, 0, kb * 64, n0, scr, F.lane); continue; } r -= I_IN;
        if (r < I_AO) { const int nb = r % (D / 32), kb = r / (D / 32); p0_transpose_item(w_ao, D, WmT, 2560, nb * 32, 0, kb * 64, nb * 32, scr, F.lane); continue; } r -= I_AO;
        if (r < I_RO) { const int nb = r % (D / 32), kb = r / (D / 32); p0_transpose_item(w_ro, D, WmT, 2560, nb * 32, 512, kb * 64, nb * 32, scr, F.lane); continue; } r -= I_RO;
        if (r < I_O) { const int nb = r % (D / 32), kb = r / (D / 32); p0_transpose_item(w_o, D, WoT, D, nb * 32, 0, kb * 64, nb * 32, scr, F.lane); continue; } r -= I_O;
        if (r < 2 * I_G) { const int up = r >= I_G; if (up) r -= I_G; const int nb = r % (DFF / 32), kb = r / (DFF / 32), n0 = nb * 32;
            const int drow0 = (n0 >> 7) * 256 + (up ? 128 : 0) + (n0 & 127);
            p0_transpose_item(up ? w_u : w_g, DFF, WguT, D, drow0, 0, kb * 64, n0, scr, F.lane); continue; } r -= 2 * I_G;
        { const int nb = r % (D / 32), kb = r / (D / 32); p0_transpose_item(w_d, D, WdT, DFF, nb * 32, 0, kb * 64, nb * 32, scr, F.lane); }
    }
}
__device__ __forceinline__ void sincos_rr(float a, float& cs, float& sn) {
    const float k = rintf(a * 0.15915494309189535f);
    float r = fmaf(-k, 6.28125f, a); r = fmaf(-k, 1.9353071795864769e-3f, r); r = fmaf(-k, 2.5e-20f, r);
#ifdef EMU
    cs = cosf(r); sn = sinf(r);
#else
    cs = __cosf(r); sn = __sinf(r);
#endif
}
__device__ __forceinline__ void p0_tables(Frame& F) {
    float* tabR = (float*)(F.ws + WS_TABR); float* tabA = (float*)(F.ws + WS_TABA);
    const int gt = F.vcu * (NWAVES * 64) + F.tid, NT = F.G * NWAVES * 64;
    for (int i = gt; i < SEQ * 128; i += NT) { const int pos = i >> 7, d = i & 127; const float inv = powf(10000.0f, -(float)d / 128.0f); const float ang = (float)pos * inv;
        float cs, sn; sincos_rr(ang, cs, sn); tabR[i] = cs; tabR[(size_t)SEQ * 128 + i] = sn; }
    for (int i = gt; i < SEQ * 16; i += NT) { const int pos = i >> 4, d = i & 15; const float inv = powf(500000.0f, -(float)d / 16.0f); const float ang = (float)pos * inv;
        float cs, sn; sincos_rr(ang, cs, sn); tabA[i] = cs; tabA[(size_t)SEQ * 16 + i] = sn; }
}
__device__ __forceinline__ void rms_row_to_bf16(const float* xrow, const float* g, bf16* orow, int lane) {
    const f32x4* xr = (const f32x4*)xrow + lane; const f32x4* gr = (const f32x4*)g + lane;
    f32x4 v[4]; float s = 0.f;
#pragma unroll
    for (int j = 0; j < 4; ++j) { v[j] = xr[64 * j]; s += (v[j].x * v[j].x + v[j].y * v[j].y) + (v[j].z * v[j].z + v[j].w * v[j].w); }
    const float rstd = 1.0f / sqrtf(wave_sum(s) * (1.0f / D) + NORM_EPS);
    unsigned long long* o8 = (unsigned long long*)orow + lane;
#pragma unroll
    for (int j = 0; j < 4; ++j) { const f32x4 gg = gr[64 * j]; o8[64 * j] = (unsigned long long)pk2(v[j].x * rstd * gg.x, v[j].y * rstd * gg.y) | ((unsigned long long)pk2(v[j].z * rstd * gg.z, v[j].w * rstd * gg.w) << 32); }
}
__device__ __forceinline__ void p_norm_rows(Frame& F, const float* X, const float* g, bf16* XN) {
    const int gw = F.vcu * NWAVES + F.wave, NGW = F.G * NWAVES;
    for (int m = gw; m < M; m += NGW) rms_row_to_bf16(X + (size_t)m * D, g, XN + (size_t)m * D, F.lane);
}
__device__ __forceinline__ void p_resid_rows(Frame& F, const float* Y, const float* Xi, float* Xo, const float* g1, const float* g2, bf16* XN) {
    const int gw = F.vcu * NWAVES + F.wave, NGW = F.G * NWAVES, lane = F.lane;
    for (int m = gw; m < M; m += NGW) {
        const f32x4* yr = (const f32x4*)(Y + (size_t)m * D) + lane; const f32x4* xr = (const f32x4*)(Xi + (size_t)m * D) + lane; f32x4* xo = (f32x4*)(Xo + (size_t)m * D) + lane;
        f32x4 v[4], x[4]; float s = 0.f;
#pragma unroll
        for (int j = 0; j < 4; ++j) { v[j] = yr[64 * j]; x[j] = xr[64 * j]; s += (v[j].x * v[j].x + v[j].y * v[j].y) + (v[j].z * v[j].z + v[j].w * v[j].w); }
        const float rstd = 1.0f / sqrtf(wave_sum(s) * (1.0f / D) + NORM_EPS); float s2 = 0.f;
#pragma unroll
        for (int j = 0; j < 4; ++j) { const f32x4 gg = ((const f32x4*)g1 + lane)[64 * j]; x[j] = x[j] + v[j] * rstd * gg; xo[64 * j] = x[j]; s2 += (x[j].x * x[j].x + x[j].y * x[j].y) + (x[j].z * x[j].z + x[j].w * x[j].w); }
        if (g2) { const float r2 = 1.0f / sqrtf(wave_sum(s2) * (1.0f / D) + NORM_EPS); unsigned long long* o8 = (unsigned long long*)(XN + (size_t)m * D) + lane;
#pragma unroll
            for (int j = 0; j < 4; ++j) { const f32x4 gg = ((const f32x4*)g2 + lane)[64 * j]; o8[64 * j] = (unsigned long long)pk2(x[j].x * r2 * gg.x, x[j].y * r2 * gg.y) | ((unsigned long long)pk2(x[j].z * r2 * gg.z, x[j].w * r2 * gg.w) << 32); } }
    }
}

__device__ __forceinline__ void att_unit_scalar(Frame& F, int u) {
    bf16* AQ = (bf16*)(F.ws + WS_ACT + A_AQ); const bf16* AK = (const bf16*)(F.ws + WS_ACT + A_AK); const bf16* AV = (const bf16*)(F.ws + WS_ACT + A_AV); float* LSE = (float*)(F.ws + WS_LSE);
    const int b = u / (12 * NBLK), rem = u % (12 * NBLK), gi = rem / (4 * NBLK), rem2 = rem % (4 * NBLK), j = rem2 / NBLK, blk = rem2 % NBLK;
    const int r = gi == 0 ? 1 : (gi == 1 ? 4 : 16), nb = NBLK / r, p = blk / nb, n = blk % nb, head = gi * 4 + j;
    LAS bf16* Kl = (LAS bf16*)(F.lds);
    LAS bf16* Vl = (LAS bf16*)(F.lds + 66560);
    LAS float* qs = (LAS float*)(F.lds + 66560 + 65536) + F.wave * 128;
    LAS float* ps = (LAS float*)(F.lds + 66560 + 65536 + 4096) + F.wave * 132;
    for (int idx = F.tid; idx < 256 * 16; idx += NWAVES * 64) {
        const int m = idx >> 4, ch = idx & 15; const int ti = 128 * (n - 1) + m;
        v4u kv = {0u, 0u, 0u, 0u}, vv = {0u, 0u, 0u, 0u};
        if (ti >= 0) { const size_t off = ((size_t)b * SEQ + p + (size_t)r * ti) * 1536 + head * 128 + ch * 8; kv = *(const v4u*)(AK + off); vv = *(const v4u*)(AV + off); }
        LAS unsigned* kd = (LAS unsigned*)(Kl + m * 130 + ch * 8); kd[0] = kv.x; kd[1] = kv.y; kd[2] = kv.z; kd[3] = kv.w;
        *(LAS v4u*)(Vl + m * 128 + ch * 8) = vv;
    }
    __syncthreads();
    const int lane = F.lane;
    for (int i = 0; i < 16; ++i) {
        const int c = F.wave * 16 + i; const size_t tok = (size_t)b * SEQ + p + (size_t)r * (128 * n + c);
        bf16* qrow = AQ + tok * 1536 + head * 128;
        { const unsigned w = *(const unsigned*)(qrow + 2 * lane); qs[2 * lane] = bflo(w); qs[2 * lane + 1] = bfhi(w); }
        WAVE_SYNC();
        float sc[3]; float mx = -3.0e38f;
#pragma unroll
        for (int kk = 0; kk < 3; ++kk) {
            const int mrel = lane + 64 * kk, m = c + mrel; const bool valid = (mrel <= 128) && (n > 0 || m >= 128);
            float s = 0.f;
            if (valid) { const LAS unsigned* kr = (const LAS unsigned*)(Kl + m * 130);
                for (int d2 = 0; d2 < 64; ++d2) { const unsigned w = kr[d2]; s += qs[2 * d2] * bflo(w) + qs[2 * d2 + 1] * bfhi(w); } }
            sc[kk] = valid ? s : -3.0e38f; mx = fmaxf(mx, sc[kk]);
        }
        mx = wave_max(mx);
        float sum = 0.f;
#pragma unroll
        for (int kk = 0; kk < 3; ++kk) { const float e = sc[kk] > -1.0e38f ? __expf(sc[kk] - mx) : 0.f; sum += e; if (lane + 64 * kk < 132) ps[lane + 64 * kk] = e; }
        sum = wave_sum(sum);
        WAVE_SYNC();
        float o0 = 0.f, o1 = 0.f;
        for (int mrel = 0; mrel <= 128; ++mrel) { const float pw = ps[mrel]; const unsigned w = *(const LAS unsigned*)(Vl + (c + mrel) * 128 + 2 * lane); o0 += pw * bflo(w); o1 += pw * bfhi(w); }
        const float inv = 1.0f / sum;
        *(unsigned*)(qrow + 2 * lane) = pk2(o0 * inv, o1 * inv);
        if (lane == 0) LSE[((size_t)gi * M + tok) * 4 + j] = mx + __logf(sum);
        WAVE_SYNC();
    }
    __syncthreads();
}
__device__ __forceinline__ void p_att_merge(Frame& F) {
    const bf16* AQ = (const bf16*)(F.ws + WS_ACT + A_AQ); bf16* AR = (bf16*)(F.ws + WS_ACT + A_AR); const float* LSE = (const float*)(F.ws + WS_LSE);
    const int gw = F.vcu * NWAVES + F.wave, NGW = F.G * NWAVES, lane = F.lane, j = lane >> 4, d0 = (lane & 15) * 8;
    for (int t = gw; t < M; t += NGW) {
        float l[3]; float mx = -3.0e38f;
#pragma unroll
        for (int g = 0; g < 3; ++g) { l[g] = LSE[((size_t)g * M + t) * 4 + j]; mx = fmaxf(mx, l[g]); }
        float w[3]; float ws_ = 0.f;
#pragma unroll
        for (int g = 0; g < 3; ++g) { w[g] = __expf(l[g] - mx); ws_ += w[g]; }
        const float inv = 1.0f / ws_;
        float o[8] = {0.f, 0.f, 0.f, 0.f, 0.f, 0.f, 0.f, 0.f};
#pragma unroll
        for (int g = 0; g < 3; ++g) { const v4u q = *(const v4u*)(AQ + (size_t)t * 1536 + (g * 4 + j) * 128 + d0); const float wg = w[g] * inv;
            o[0] += wg * bflo(q.x); o[1] += wg * bfhi(q.x); o[2] += wg * bflo(q.y); o[3] += wg * bfhi(q.y); o[4] += wg * bflo(q.z); o[5] += wg * bfhi(q.z); o[6] += wg * bflo(q.w); o[7] += wg * bfhi(q.w); }
        v4u ov; ov.x = pk2(o[0], o[1]); ov.y = pk2(o[2], o[3]); ov.z = pk2(o[4], o[5]); ov.w = pk2(o[6], o[7]);
        *(v4u*)(AR + (size_t)t * 2560 + j * 128 + d0) = ov;
    }
}

struct RetConst { float lg, a, a8; };
__device__ __forceinline__ RetConst ret_const(int h) { RetConst c; c.lg = logf(1.0f - exp2f(-5.0f - (float)h)); c.a = expf(128.0f * c.lg); c.a8 = expf(1024.0f * c.lg); return c; }
__device__ __forceinline__ void ret_pass1_scalar(Frame& F, int ur) {
    const bf16* RK = (const bf16*)(F.ws + WS_ACT + A_RK); const bf16* RV = (const bf16*)(F.ws + WS_ACT + A_RV); float* FS = (float*)(F.ws + WS_ACT + A_F);
    const int g = ur % NSEG, s = (ur / NSEG) & 3, h = (ur / (NSEG * 4)) & 3, b = ur / (NSEG * 16);
    const RetConst rc = ret_const(h);
    const int dv = F.tid & 127, dkg = F.tid >> 7;
    float R[64];
#pragma unroll
    for (int jj = 0; jj < 64; ++jj) R[jj] = 0.f;
    for (int i = 0; i < 8; ++i) {
        const size_t tb = (size_t)b * SEQ + (size_t)(g * 8 + i) * 128;
#pragma unroll
        for (int jj = 0; jj < 64; ++jj) R[jj] *= rc.a;
        for (int c = 0; c < 128; ++c) {
            const float v = bf2f(RV[(tb + c) * 2048 + h * 512 + s * 128 + dv]) * expf((float)(127 - c) * rc.lg);
            const v4u* kp = (const v4u*)(RK + (tb + c) * 1024 + h * 256 + dkg * 64);
#pragma unroll
            for (int q = 0; q < 8; ++q) { const v4u k = kp[q];
                R[8 * q + 0] += bflo(k.x) * v; R[8 * q + 1] += bfhi(k.x) * v; R[8 * q + 2] += bflo(k.y) * v; R[8 * q + 3] += bfhi(k.y) * v;
                R[8 * q + 4] += bflo(k.z) * v; R[8 * q + 5] += bfhi(k.z) * v; R[8 * q + 6] += bflo(k.w) * v; R[8 * q + 7] += bfhi(k.w) * v; }
        }
    }
    float* fo = FS + (size_t)ur * 32768;
#pragma unroll
    for (int jj = 0; jj < 64; ++jj) fo[(dkg * 64 + jj) * 128 + dv] = R[jj];
}
__device__ __forceinline__ void ret_pass2_scalar(Frame& F, int ur) {
    const bf16* RQ = (const bf16*)(F.ws + WS_ACT + A_RQ); const bf16* RK = (const bf16*)(F.ws + WS_ACT + A_RK); bf16* RV = (bf16*)(F.ws + WS_ACT + A_RV); const float* FS = (const float*)(F.ws + WS_ACT + A_F);
    const int g = ur % NSEG, s = (ur / NSEG) & 3, h = (ur / (NSEG * 4)) & 3, b = ur / (NSEG * 16);
    const RetConst rc = ret_const(h);
    const int tid = F.tid, dv = tid & 127, dkg = tid >> 7;
    LAS bf16* Rl = (LAS bf16*)(F.lds);
    LAS bf16* Sl = (LAS bf16*)(F.lds + 65536);
    LAS bf16* Vl = (LAS bf16*)(F.lds + 65536 + 32768);
    float R[64];
#pragma unroll
    for (int jj = 0; jj < 64; ++jj) R[jj] = 0.f;
    for (int gp = 0; gp < g; ++gp) { const float wgt = expf((float)(1024 * (g - 1 - gp)) * rc.lg); const float* fi = FS + (size_t)(ur - g + gp) * 32768;
#pragma unroll
        for (int jj = 0; jj < 64; ++jj) R[jj] += wgt * fi[(dkg * 64 + jj) * 128 + dv]; }
    for (int i = 0; i < 8; ++i) {
        const size_t tb = (size_t)b * SEQ + (size_t)(g * 8 + i) * 128;
#pragma unroll
        for (int jj = 0; jj < 64; ++jj) Rl[(dkg * 64 + jj) * 128 + dv] = (bf16)f2bf(R[jj]);
        for (int e = tid; e < 128 * 128; e += NWAVES * 64) { const int c = e >> 7;  Vl[e] = RV[(tb + c) * 2048 + h * 512 + s * 128 + (e & 127)]; }
        for (int e = tid; e < 128 * 128; e += NWAVES * 64) { const int c = e >> 7, cp = e & 127; float sv = 0.f;
            if (cp <= c) { const v4u* qp = (const v4u*)(RQ + (tb + c) * 1024 + h * 256); const v4u* kp = (const v4u*)(RK + (tb + cp) * 1024 + h * 256);
                for (int q = 0; q < 32; ++q) { const v4u a = qp[q], k = kp[q];
                    sv += bflo(a.x) * bflo(k.x) + bfhi(a.x) * bfhi(k.x) + bflo(a.y) * bflo(k.y) + bfhi(a.y) * bfhi(k.y) + bflo(a.z) * bflo(k.z) + bfhi(a.z) * bfhi(k.z) + bflo(a.w) * bflo(k.w) + bfhi(a.w) * bfhi(k.w); }
                sv *= expf((float)(c - cp) * rc.lg); }
            Sl[e] = (bf16)f2bf(sv); }
        __syncthreads();
        for (int ci = 0; ci < 32; ++ci) { const int c = dkg * 32 + ci; float cross = 0.f, intra = 0.f;
            const v4u* qp = (const v4u*)(RQ + (tb + c) * 1024 + h * 256);
            for (int q = 0; q < 32; ++q) { const v4u a = qp[q]; const LAS bf16* rp = Rl + (8 * q) * 128 + dv;
                cross += bflo(a.x) * bf2f(rp[0]) + bfhi(a.x) * bf2f(rp[128]) + bflo(a.y) * bf2f(rp[256]) + bfhi(a.y) * bf2f(rp[384]) + bflo(a.z) * bf2f(rp[512]) + bfhi(a.z) * bf2f(rp[640]) + bflo(a.w) * bf2f(rp[768]) + bfhi(a.w) * bf2f(rp[896]); }
            for (int cp = 0; cp <= c; ++cp) intra += bf2f(Sl[c * 128 + cp]) * bf2f(Vl[cp * 128 + dv]);
            const float y = expf((float)(c + 1) * rc.lg) * cross + intra;
            RV[(tb + c) * 2048 + h * 512 + s * 128 + dv] = (bf16)f2bf(y); }
#pragma unroll
        for (int jj = 0; jj < 64; ++jj) R[jj] *= rc.a;
        for (int c = 0; c < 128; ++c) {
            const float v = bf2f(Vl[c * 128 + dv]) * expf((float)(127 - c) * rc.lg);
            const v4u* kp = (const v4u*)(RK + (tb + c) * 1024 + h * 256 + dkg * 64);
#pragma unroll
            for (int q = 0; q < 8; ++q) { const v4u k = kp[q];
                R[8 * q + 0] += bflo(k.x) * v; R[8 * q + 1] += bfhi(k.x) * v; R[8 * q + 2] += bflo(k.y) * v; R[8 * q + 3] += bfhi(k.y) * v;
                R[8 * q + 4] += bflo(k.z) * v; R[8 * q + 5] += bfhi(k.z) * v; R[8 * q + 6] += bflo(k.w) * v; R[8 * q + 7] += bfhi(k.w) * v; }
        }
        __syncthreads();
    }
}
__device__ __forceinline__ void p_ret_finalize(Frame& F) {
    const bf16* Y = (const bf16*)(F.ws + WS_ACT + A_RV); bf16* AR = (bf16*)(F.ws + WS_ACT + A_AR);
    const int gw = F.vcu * NWAVES + F.wave, NGW = F.G * NWAVES, lane = F.lane;
    for (int rr = gw; rr < M * 4; rr += NGW) { const int t = rr >> 2, h = rr & 3;
        const v4u q = *(const v4u*)(Y + (size_t)t * 2048 + h * 512 + lane * 8);
        float y[8] = {bflo(q.x), bfhi(q.x), bflo(q.y), bfhi(q.y), bflo(q.z), bfhi(q.z), bflo(q.w), bfhi(q.w)};
        float s = 0.f;
#pragma unroll
        for (int e = 0; e < 8; ++e) s += y[e];
        const float mu = wave_sum(s) * (1.0f / 512.0f); float s2 = 0.f;
#pragma unroll
        for (int e = 0; e < 8; ++e) { y[e] -= mu; s2 += y[e] * y[e]; }
        const float rstd = 1.0f / sqrtf(wave_sum(s2) * (1.0f / 512.0f) + NORM_EPS);
        bf16* ap = AR + (size_t)t * 2560 + 512 + h * 512 + lane * 8; const v4u gq = *(const v4u*)ap;
        v4u o; o.x = pk2(bflo(gq.x) * y[0] * rstd, bfhi(gq.x) * y[1] * rstd); o.y = pk2(bflo(gq.y) * y[2] * rstd, bfhi(gq.y) * y[3] * rstd);
        o.z = pk2(bflo(gq.z) * y[4] * rstd, bfhi(gq.z) * y[5] * rstd); o.w = pk2(bflo(gq.w) * y[6] * rstd, bfhi(gq.w) * y[7] * rstd);
        *(v4u*)ap = o; }
}

constexpr int N_PHASES = 1 + 14 * DEPTH;
struct Args { const float* in[12]; float* out; unsigned char* ws; int ph_lo, ph_hi, li, pad; };
__global__ void __launch_bounds__(NWAVES * 64, 2) mk_fwd(Args args) {
#ifdef EMU
    unsigned char* lds = EMU_LDS_PTR;
#else
    extern __shared__ __attribute__((aligned(16))) unsigned char lds[];
#endif
    Frame F;
    F.lds = (LAS unsigned char*)lds;
    F.MISC = (volatile LAS unsigned*)(F.lds + MISC_OFF);
    F.tid = threadIdx.x; F.lane = F.tid & 63; F.wave = __builtin_amdgcn_readfirstlane(F.tid >> 6);
    F.G = gridDim.x; { const int bx = blockIdx.x; F.vcu = (F.G % 8 == 0) ? (bx % 8) * (F.G / 8) + bx / 8 : bx; }
    F.ws = args.ws; F.ctl = (gu32*)(args.ws + WS_CTL);
    for (int u = F.tid; u < (LDS_BYTES - LDSCTL_OFF) / 4; u += NWAVES * 64) ((LAS unsigned*)(F.lds + LDSCTL_OFF))[u] = 0u;
    __syncthreads();
    const bool one_launch = (MK_N_LAUNCHES == 1);
    XcdBarrier bar; bar.bar = (unsigned*)(F.ctl + CW_BAR); bar.x = 0; bar.st = nullptr;
    if (one_launch) bar = xcd_barrier_post((unsigned*)(F.ctl + CW_BAR), F.MISC + 8);
    const int lo = args.ph_lo, hi = args.ph_hi;
    unsigned char* act = F.ws + WS_ACT;
    bf16* XN = (bf16*)(F.ws + WS_XN);
    const bf16* WinT = (const bf16*)(F.ws + WS_WIN); const bf16* WmT = (const bf16*)(F.ws + WS_WM); const bf16* WoT = (const bf16*)(F.ws + WS_WO); const bf16* WguT = (const bf16*)(F.ws + WS_WGU); const bf16* WdT = (const bf16*)(F.ws + WS_WD);

#ifndef DIS
#define DIS 0
#endif
#define PH(k) (lo <= (k) && (k) < hi)
#define EN(k) (!((DIS >> (k)) & 1))
#ifdef EMU
#define REFRESH() ((void)0)
#else
#define REFRESH() do { int t_ = threadIdx.x; asm volatile("" : "+v"(t_)); F.tid = t_; F.lane = t_ & 63; F.wave = __builtin_amdgcn_readfirstlane(t_ >> 6); \
    unsigned char* w_ = args.ws; asm volatile("" : "+s"(w_)); F.ws = w_; F.ctl = (gu32*)(w_ + WS_CTL); act = w_ + WS_ACT; XN = (bf16*)(w_ + WS_XN); \
    WinT = (const bf16*)(w_ + WS_WIN); WmT = (const bf16*)(w_ + WS_WM); WoT = (const bf16*)(w_ + WS_WO); WguT = (const bf16*)(w_ + WS_WGU); WdT = (const bf16*)(w_ + WS_WD); } while (0)
#endif
#define SEAM(k) do { if (one_launch && PH(k) && PH((k) + 1)) xcd_barrier(bar); } while (0)
    if (PH(0)) { REFRESH(); if (EN(14)) p0_weights(F, args.in, 0); p0_tables(F); p_norm_rows(F, args.in[0], args.in[8], XN); }
    SEAM(0);
#pragma unroll
    for (int l = 0; l < DEPTH; ++l) {
        const int pb = 1 + 14 * l;
        if (PH(pb + 0) && EN(0)) { REFRESH(); { pg8::Gemm g{XN, WinT, M, NATT, D, D, D}; pg8::StaticOrder S; S.init(M, NATT, F.G, (int)blockIdx.x);
            pg8::EpiAtt E{(bf16*)(act + A_AQ), (A_AK - A_AQ) / 2, (const float*)(F.ws + WS_TABA)};
            pg8::gemm_phase<pg8::EpiAtt, pg8::StaticOrder, true, true>(F.lds + RING_OFF, g, S, E); }
        }
        SEAM(pb + 0);
        if (PH(pb + 1) && EN(1)) { REFRESH(); { for (int u = F.vcu; u < NAU; u += F.G) att_unit_scalar(F, u); }
        }
        SEAM(pb + 1);
        if (PH(pb + 2) && EN(2)) { REFRESH(); p_att_merge(F);
        }
        SEAM(pb + 2);
        if (PH(pb + 3) && EN(3)) { REFRESH(); { pg8::Gemm g{XN, WinT + (size_t)NATT * D, M, NRET, D, D, D}; pg8::StaticOrder S; S.init(M, NRET, F.G, (int)blockIdx.x);
            pg8::EpiRet E{(bf16*)act, (const float*)(F.ws + WS_TABR)};
            pg8::gemm_phase<pg8::EpiRet, pg8::StaticOrder, true, true>(F.lds + RING_OFF, g, S, E); }
        }
        SEAM(pb + 3);
        if (PH(pb + 4) && EN(4)) { REFRESH(); { for (int u = F.vcu; u < NRU; u += F.G) ret_pass1_scalar(F, u); }
        }
        SEAM(pb + 4);
        if (PH(pb + 5) && EN(5)) { REFRESH(); { for (int u = F.vcu; u < NRU; u += F.G) ret_pass2_scalar(F, u); }
        }
        SEAM(pb + 5);
        if (PH(pb + 6) && EN(6)) { REFRESH(); p_ret_finalize(F);
        }
        SEAM(pb + 6);
        if (PH(pb + 7) && EN(7)) { REFRESH(); { pg8::Gemm g{(const bf16*)(act + A_AR), WmT, M, D, 512, 2560, 2560}; pg8::StaticOrder S; S.init(M, D, F.G, (int)blockIdx.x);
            pg8::EpiGate E{(float*)(act + A_T), nullptr, D, (const bf16*)(act + A_GA), D, nullptr, 0};
            pg8::gemm_phase<pg8::EpiGate, pg8::StaticOrder, true, true>(F.lds + RING_OFF, g, S, E); }
        }
        SEAM(pb + 7);
        if (PH(pb + 8) && EN(8)) { REFRESH(); { pg8::Gemm g{(const bf16*)(act + A_AR) + 512, WmT + 512, M, D, 2048, 2560, 2560}; pg8::StaticOrder S; S.init(M, D, F.G, (int)blockIdx.x);
            pg8::EpiGate E{nullptr, (bf16*)(act + A_MG), D, (const bf16*)(act + A_GR), D, (const float*)(act + A_T), D};
            pg8::gemm_phase<pg8::EpiGate, pg8::StaticOrder, true, true>(F.lds + RING_OFF, g, S, E); }
        }
        SEAM(pb + 8);
        if (PH(pb + 9) && EN(9)) { REFRESH(); { pg8::Gemm g{(const bf16*)(act + A_MG), WoT, M, D, D, D, D}; pg8::StaticOrder S; S.init(M, D, F.G, (int)blockIdx.x);
            pg8::EpiGate E{(float*)(act + A_M32), nullptr, D, nullptr, 0, nullptr, 0};
            pg8::gemm_phase<pg8::EpiGate, pg8::StaticOrder, true, true>(F.lds + RING_OFF, g, S, E); }
        }
        SEAM(pb + 9);
        if (PH(pb + 10) && EN(10)) { REFRESH(); p_resid_rows(F, (const float*)(act + A_M32), l == 0 ? args.in[0] : args.out, args.out, args.in[9] + (size_t)l * D, args.in[10] + (size_t)l * D, XN);
        }
        SEAM(pb + 10);
        if (PH(pb + 11) && EN(11)) { REFRESH(); { pg8::Gemm g{XN, WguT, M, 2 * DFF, D, D, D}; pg8::StaticOrder S; S.init(M, 2 * DFF, F.G, (int)blockIdx.x);
            pg8::EpiSwiGLU E{(bf16*)(act + A_ACT), DFF};
            pg8::gemm_phase<pg8::EpiSwiGLU, pg8::StaticOrder, true, true>(F.lds + RING_OFF, g, S, E); }
        }
        SEAM(pb + 11);
        if (PH(pb + 12) && EN(12)) { REFRESH(); { pg8::Gemm g{(const bf16*)(act + A_ACT), WdT, M, D, DFF, DFF, DFF}; pg8::StaticOrder S; S.init(M, D, F.G, (int)blockIdx.x);
            pg8::EpiGate E{(float*)(act + A_F32), nullptr, D, nullptr, 0, nullptr, 0};
            pg8::gemm_phase<pg8::EpiGate, pg8::StaticOrder, true, true>(F.lds + RING_OFF, g, S, E); }
        }
        SEAM(pb + 12);
        if (PH(pb + 13) && EN(13)) { REFRESH(); { const bool more = (l + 1 < DEPTH);
            p_resid_rows(F, (const float*)(act + A_F32), args.out, args.out, args.in[11] + (size_t)l * D, more ? args.in[8] + (size_t)(l + 1) * D : nullptr, XN);
            if (more) p0_weights(F, args.in, l + 1); }
        }
        SEAM(pb + 13);
    }
}

extern "C" void kernel_launch(void* const* d_in, const int* in_sizes, int n_in, void* d_out, int out_size, void* d_ws, size_t ws_size, hipStream_t stream) {
    static int grid = 0;
    if (grid == 0) {
        if (n_in != 12 || in_sizes[0] != M * D || out_size != M * D || ws_size < WS_END) { fprintf(stderr, "kernel_launch: unexpected shapes (n_in %d, in0 %d, out %d, ws %zu need %zu); nothing launched\n", n_in, n_in > 0 ? in_sizes[0] : -1, out_size, ws_size, (size_t)WS_END); grid = -1; return; }
        int dev = 0, cus = 0, per_cu = 0;
        if (hipGetDevice(&dev) != hipSuccess || hipDeviceGetAttribute(&cus, hipDeviceAttributeMultiprocessorCount, dev) != hipSuccess) { grid = -1; return; }
        if (hipFuncSetAttribute((const void*)mk_fwd, hipFuncAttributeMaxDynamicSharedMemorySize, LDS_BYTES) != hipSuccess) { fprintf(stderr, "kernel_launch: hipFuncSetAttribute failed\n"); grid = -1; return; }
        if (hipOccupancyMaxActiveBlocksPerMultiprocessor(&per_cu, (const void*)mk_fwd, NWAVES * 64, LDS_BYTES) != hipSuccess || per_cu < 1) fprintf(stderr, "kernel_launch: occupancy query reports %d\n", per_cu);
        (void)hipGetLastError();
        grid = cus;
    }
    if (grid < 0) return;
    if (hipMemsetAsync((char*)d_ws + WS_CTL, 0, CTL_ZERO_BYTES, stream) != hipSuccess) return;
    Args a{};
    for (int i = 0; i < 12; ++i) a.in[i] = (const float*)d_in[i];
    a.out = (float*)d_out; a.ws = (unsigned char*)d_ws;
    if (MK_N_LAUNCHES == 1) { a.ph_lo = 0; a.ph_hi = N_PHASES; a.li = 0; hipLaunchKernelGGL(mk_fwd, dim3(grid), dim3(NWAVES * 64), LDS_BYTES, stream, a); }
    else for (int ph = 0; ph < N_PHASES; ++ph) { a.ph_lo = ph; a.ph_hi = ph + 1; a.li = ph; hipLaunchKernelGGL(mk_fwd, dim3(grid), dim3(NWAVES * 64), LDS_BYTES, stream, a); }
}
```

```cpp
#ifdef EMU
#include "emu.h"
#else
#include <hip/hip_runtime.h>
#endif
#include <cstdio>
#include <cstdint>
#include <cmath>

#ifndef CFG_BATCH
#define CFG_BATCH 2
#endif
#ifndef CFG_SEQ
#define CFG_SEQ 8192
#endif
#ifndef MK_N_LAUNCHES
#define MK_N_LAUNCHES 1
#endif

#ifdef EMU
#define PG8_LAS
#define GAS
#define LAS
#define ASM_WAIT(s) ((void)0)
#define OPAQUE_V(x) ((void)0)
#define GLDS16(gp, lp) emu_global_load_lds16((const void*)(gp), (void*)(lp))
#else
#define PG8_LAS __attribute__((address_space(3)))
#define GAS __attribute__((address_space(1)))
#define LAS __attribute__((address_space(3)))
#define ASM_WAIT(s) asm volatile(s ::: "memory")
#define OPAQUE_V(x) asm volatile("" : "+v"(x))
#define GLDS16(gp, lp) __builtin_amdgcn_global_load_lds((const unsigned*)(gp), (PG8_LAS unsigned*)(lp), 16, 0, 0)
#endif

constexpr int NWAVES = 8;
constexpr int BATCH = CFG_BATCH, SEQ = CFG_SEQ, D = 1024, M = BATCH * SEQ;
constexpr int DIN = 12800, NATT = 4608, NRET = 8192, DFF = 2816, DEPTH = 2;
constexpr int NSEG = SEQ / 1024;
constexpr int NRU = BATCH * 4 * 4 * NSEG;
constexpr int NBLK = SEQ / 128;
constexpr int NAU = BATCH * 12 * NBLK;
constexpr float NORM_EPS = 1e-6f;
static_assert(SEQ % 2048 == 0 && M % 256 == 0, "shape");

constexpr size_t MiB = 1u << 20;
constexpr size_t WS_CTL = 0, CTL_ZERO_BYTES = 1 * MiB;
constexpr size_t WS_WIN = 1 * MiB, WS_WM = 26 * MiB, WS_WO = 31 * MiB, WS_WGU = 33 * MiB, WS_WD = 44 * MiB;
constexpr size_t WS_TABR = 50 * MiB, WS_TABA = 58 * MiB, WS_LSE = 59 * MiB, WS_XN = 60 * MiB, WS_ACT = 92 * MiB;
constexpr size_t RB = (size_t)M * 2048;
constexpr size_t A_AQ = 0, A_AK = RB * 3 / 2, A_AV = RB * 3;
constexpr size_t A_RQ = 0, A_RK = RB, A_RV = 2 * RB, A_AR = 4 * RB, A_GR = RB * 13 / 2, A_GA = RB * 15 / 2, A_F = RB * 17 / 2;
constexpr size_t A_T = 0, A_MG = 2 * RB, A_M32 = 0, A_ACT = 3 * RB, A_F32 = 0;
constexpr size_t WS_END = WS_ACT + RB * 19 / 2;
static_assert(A_AV - A_AK == A_AK - A_AQ && WS_END <= 400 * MiB, "d_ws map");
static_assert((size_t)SEQ * 128 * 4 * 2 <= 8 * MiB && (size_t)3 * M * 4 * 4 <= MiB && (size_t)M * D * 2 <= 32 * MiB, "d_ws map");
constexpr int CW_TMO = 0, CW_CODE = 1, CW_BAR = 4096;

namespace pg8 {
typedef unsigned short bf16_t;
typedef short bf16x8 __attribute__((ext_vector_type(8)));
typedef float f32x4 __attribute__((ext_vector_type(4)));
typedef unsigned u32x4 __attribute__((ext_vector_type(4)));
constexpr int BM = 256, BK = 64, HALF = 128, HTB = HALF * BK * 2  , STAGE_BYTES = 8 * HTB, NXCD = 8, WGM = 8;

__host__ __device__ __forceinline__ int lds_byte(int r, int c) { const int st = (r >> 4) * 2 + (c >> 5), rr = r & 15, cc = c & 31, ob = rr * 64 + cc * 2; return st * 1024 + (ob ^ (((ob >> 9) & 1) << 5)); }
__host__ __device__ __forceinline__ void stage_rc(int b, int& R, int& C) { const int st = b / 1024, sb = b % 1024, swz = sb ^ (((sb >> 9) & 1) << 5); R = (st >> 1) * 16 + swz / 64; C = (st & 1) * 32 + (swz % 64) / 2; }
__host__ __device__ __forceinline__ int perm32(int rho) { const int n = rho >> 4, i = rho & 15; return 8 * (i >> 2) + 4 * n + (i & 3); }

struct Unit { int pm, pn; };
struct Gemm { const bf16_t* A; const bf16_t* Bt; int M, N, K, lda, ldb; };

struct StaticOrder {
    int nM, nN, nwg, G, c;
    __host__ __device__ void init(int M, int N, int G_, int c_) { nM = M / BM; nN = N / BM; nwg = nM * nN; G = G_; c = c_; }
    __host__ __device__ bool next(int i, Unit& u) const {
        const long L = (long)i * G + c; if (L >= nwg) return false;
        int wgid = (int)L; { const int q = nwg / NXCD, r = nwg % NXCD, xcd = wgid % NXCD, off = wgid / NXCD; wgid = (xcd < r ? xcd * (q + 1) : r * (q + 1) + (xcd - r) * q) + off; }
        const int nig = WGM * nN, gid = wgid / nig, fm = gid * WGM, gsz = (nM - fm) < WGM ? (nM - fm) : WGM;
        u.pm = fm + ((wgid % nig) % gsz); u.pn = (wgid % nig) / gsz; return true;
    }
    __device__ __forceinline__ void a_ready(const Unit&) const {}
    __device__ __forceinline__ void done(const Unit&) const {}
};

#ifdef EMU
__device__ __forceinline__ unsigned cvt_pk_bf16(float lo, float hi) { return (unsigned)emu::f2bf(lo) | ((unsigned)emu::f2bf(hi) << 16); }
#else
__device__ __forceinline__ unsigned cvt_pk_bf16(float lo, float hi) { unsigned r; asm volatile("v_cvt_pk_bf16_f32 %0, %1, %2" : "=v"(r) : "v"(lo), "v"(hi)); return r; }
#endif
__device__ __forceinline__ u32x4 pack8(const f32x4 v0, const f32x4 v1) { u32x4 w; w.x = cvt_pk_bf16(v0[0], v0[1]); w.y = cvt_pk_bf16(v0[2], v0[3]); w.z = cvt_pk_bf16(v1[0], v1[1]); w.w = cvt_pk_bf16(v1[2], v1[3]); return w; }
__device__ __forceinline__ float fast_sigmoid(float x) { return __builtin_amdgcn_rcpf(1.0f + __expf(-x)); }
__device__ __forceinline__ f32x4 sigmoid4(const f32x4 v) { return (f32x4){fast_sigmoid(v[0]), fast_sigmoid(v[1]), fast_sigmoid(v[2]), fast_sigmoid(v[3])}; }
__device__ __forceinline__ f32x4 silu4(const f32x4 v) { return v * sigmoid4(v); }
struct EpiAtt {
    static constexpr bool PERM = true, AFTER_DRAIN = false;
    bf16_t* AQ; size_t tstride; const float* tabA;
    __device__ __forceinline__ void operator()(const f32x4 (&acc)[2][2][4][2], const Unit& u, int wr, int wc, int fr, int fq) const {
        const int t = u.pn / 6, ct = u.pn - 6 * t;
        bf16_t* base = AQ + (size_t)t * tstride;
        const float sc = (t == 0) ? 0.08838834764831845f : 1.0f;
        const int row0 = u.pm * BM + wr * 64 + fr, col0 = ct * BM + wc * 32 + 8 * fq;
        const bool rot = (t < 2) && (wc == 0);
        const float* cosT = tabA; const float* sinT = tabA + (size_t)CFG_SEQ * 16;
#pragma unroll
        for (int ai = 0; ai < 2; ++ai)
#pragma unroll
            for (int m = 0; m < 4; ++m) {
                const int row = row0 + ai * HALF + m * 16; bf16_t* rowp = base + (size_t)row * 1536 + col0;
                f32x4 c0 = {1.f, 1.f, 1.f, 1.f}, c1 = c0, s0 = {0.f, 0.f, 0.f, 0.f}, s1 = s0;
                if (rot) { const int pos = row % CFG_SEQ; const float* cp = cosT + (size_t)pos * 16 + 8 * (fq & 1); const float* sp = sinT + (size_t)pos * 16 + 8 * (fq & 1);
                    c0 = *(const f32x4*)cp; c1 = *(const f32x4*)(cp + 4); s0 = *(const f32x4*)sp; s1 = *(const f32x4*)(sp + 4); }
#pragma unroll
                for (int bj = 0; bj < 2; ++bj) {
                    f32x4 v0 = acc[ai][bj][m][0], v1 = acc[ai][bj][m][1];
                    if (rot) {
                        f32x4 o0, o1;
#pragma unroll
                        for (int e = 0; e < 4; ++e) { o0[e] = __shfl_xor(v0[e], 32); o1[e] = __shfl_xor(v1[e], 32); }
                        if (fq < 2) { v0 = v0 * c0 - o0 * s0; v1 = v1 * c1 - o1 * s1; }
                        else        { v0 = o0 * s0 + v0 * c0; v1 = o1 * s1 + v1 * c1; }
                    }
                    v0 = v0 * sc; v1 = v1 * sc;
                    *(u32x4*)(rowp + bj * HALF) = pack8(v0, v1);
                }
            }
    }
};
struct EpiRet {
    static constexpr bool PERM = true, AFTER_DRAIN = false;
    bf16_t* act; const float* tabR;
    static constexpr size_t oRQ = A_RQ / 2, oRK = A_RK / 2, oRV = A_RV / 2, oAR = A_AR / 2, oGR = A_GR / 2, oGA = A_GA / 2;
    __device__ __forceinline__ void operator()(const f32x4 (&acc)[2][2][4][2], const Unit& u, int wr, int wc, int fr, int fq) const {
        const int pn = u.pn; const int row0 = u.pm * BM + wr * 64 + fr, cw = wc * 32 + 8 * fq;
        if (pn < 8) {
            bf16_t* base = act + (pn < 4 ? oRQ : oRK); const float sc = pn < 4 ? 1.0f : 0.0625f; const int colh = (pn & 3) * 256 + cw;
            const float* cosT = tabR; const float* sinT = tabR + (size_t)CFG_SEQ * 128;
#pragma unroll
            for (int ai = 0; ai < 2; ++ai)
#pragma unroll
                for (int m = 0; m < 4; ++m) {
                    const int row = row0 + ai * HALF + m * 16, pos = row % CFG_SEQ; bf16_t* rowp = base + (size_t)row * 1024 + colh;
                    const float* cp = cosT + (size_t)pos * 128 + cw; const float* sp = sinT + (size_t)pos * 128 + cw;
                    const f32x4 c0 = *(const f32x4*)cp, c1 = *(const f32x4*)(cp + 4), s0 = *(const f32x4*)sp, s1 = *(const f32x4*)(sp + 4);
                    const f32x4 a0 = acc[ai][0][m][0], a1 = acc[ai][0][m][1], b0 = acc[ai][1][m][0], b1 = acc[ai][1][m][1];
                    *(u32x4*)(rowp) = pack8((a0 * c0 - b0 * s0) * sc, (a1 * c1 - b1 * s1) * sc);
                    *(u32x4*)(rowp + HALF) = pack8((a0 * s0 + b0 * c0) * sc, (a1 * s1 + b1 * c1) * sc);
                }
        } else {
            size_t boff; int ldc, col; int mode;
            if (pn < 16)      { boff = oRV; ldc = 2048; col = (pn - 8) * 256; mode = 0; }
            else if (pn < 24) { boff = oAR; ldc = 2560; col = 512 + (pn - 16) * 256; mode = 1; }
            else if (pn < 28) { boff = oGR; ldc = 1024; col = (pn - 24) * 256; mode = 2; }
            else              { boff = oGA; ldc = 1024; col = (pn - 28) * 256; mode = 2; }
            bf16_t* base = act + boff;
#pragma unroll
            for (int ai = 0; ai < 2; ++ai)
#pragma unroll
                for (int m = 0; m < 4; ++m) {
                    bf16_t* rowp = base + (size_t)(row0 + ai * HALF + m * 16) * ldc + col + cw;
#pragma unroll
                    for (int bj = 0; bj < 2; ++bj) {
                        f32x4 v0 = acc[ai][bj][m][0], v1 = acc[ai][bj][m][1];
                        if (mode == 1) { v0 = silu4(v0); v1 = silu4(v1); } else if (mode == 2) { v0 = sigmoid4(v0); v1 = sigmoid4(v1); }
                        *(u32x4*)(rowp + bj * HALF) = pack8(v0, v1);
                    }
                }
        }
    }
};
struct EpiGate {
    static constexpr bool PERM = true, AFTER_DRAIN = false;
    float* O32; bf16_t* O16; int ldc; const bf16_t* gate; int ldg; const float* add; int lda_;
    __device__ __forceinline__ void operator()(const f32x4 (&acc)[2][2][4][2], const Unit& u, int wr, int wc, int fr, int fq) const {
        const int row0 = u.pm * BM + wr * 64 + fr, col0 = u.pn * BM + wc * 32 + 8 * fq;
#pragma unroll
        for (int ai = 0; ai < 2; ++ai)
#pragma unroll
            for (int m = 0; m < 4; ++m) {
                const size_t row = (size_t)(row0 + ai * HALF + m * 16);
#pragma unroll
                for (int bj = 0; bj < 2; ++bj) {
                    f32x4 v0 = acc[ai][bj][m][0], v1 = acc[ai][bj][m][1]; const int col = col0 + bj * HALF;
                    if (gate) { const u32x4 g = *(const u32x4*)(gate + row * ldg + col);
                        v0 = v0 * (f32x4){__uint_as_float(g.x << 16), __uint_as_float(g.x & 0xffff0000u), __uint_as_float(g.y << 16), __uint_as_float(g.y & 0xffff0000u)};
                        v1 = v1 * (f32x4){__uint_as_float(g.z << 16), __uint_as_float(g.z & 0xffff0000u), __uint_as_float(g.w << 16), __uint_as_float(g.w & 0xffff0000u)}; }
                    if (add) { v0 = v0 + *(const f32x4*)(add + row * lda_ + col); v1 = v1 + *(const f32x4*)(add + row * lda_ + col + 4); }
                    if (O32) { *(f32x4*)(O32 + row * ldc + col) = v0; *(f32x4*)(O32 + row * ldc + col + 4) = v1; }
                    if (O16) *(u32x4*)(O16 + row * ldc + col) = pack8(v0, v1);
                }
            }
    }
};
struct EpiSwiGLU {
    static constexpr bool PERM = true, AFTER_DRAIN = false;
    bf16_t* O; int ldc;
    __device__ __forceinline__ void operator()(const f32x4 (&acc)[2][2][4][2], const Unit& u, int wr, int wc, int fr, int fq) const {
        const int row0 = u.pm * BM + wr * 64 + fr, col0 = u.pn * HALF + wc * 32 + 8 * fq;
#pragma unroll
        for (int ai = 0; ai < 2; ++ai)
#pragma unroll
            for (int m = 0; m < 4; ++m) {
                const size_t row = (size_t)(row0 + ai * HALF + m * 16);
                const f32x4 v0 = silu4(acc[ai][0][m][0]) * acc[ai][1][m][0], v1 = silu4(acc[ai][0][m][1]) * acc[ai][1][m][1];
                *(u32x4*)(O + row * ldc + col0) = pack8(v0, v1);
            }
    }
};

template <class Epi, class Sched, bool ALIGN_EPI = false, bool SP2 = false>
__device__ __forceinline__ void gemm_phase(PG8_LAS unsigned char* lds, const Gemm g, const Sched& S, const Epi& E) {
    int tid_ = threadIdx.x; OPAQUE_V(tid_); const int tid = tid_, wid = __builtin_amdgcn_readfirstlane(tid >> 6), lane = tid & 63, wr = wid >> 2, wc = wid & 3, fr = lane & 15, fq = lane >> 4;
    const int K = g.K, nt = K / BK;
    unsigned voffA[2], voffB[2];
#pragma unroll
    for (int i = 0; i < 2; ++i) { int R, C; stage_rc(tid * 16 + i * 8192, R, C); const int Rb = Epi::PERM ? ((R & ~31) + perm32(R & 31)) : R;
        voffA[i] = (unsigned)(R * g.lda + C) * 2u; voffB[i] = (unsigned)(Rb * g.ldb + C) * 2u; }
    const size_t kstep = (size_t)(BK * 2);
    const size_t hstepA = (size_t)HALF * g.lda * 2, hstepB = (size_t)HALF * g.ldb * 2;
    const size_t tstepA = 2 * hstepA, tstepB = 2 * hstepB;
    const unsigned ldsw = (unsigned)wid * 1024u;
    const int aoff = lds_byte(wr * 64 + fr, fq * 8), boff = lds_byte(wc * 32 + fr, fq * 8);
#define PG8_SA(b, h) (((b) * 2 + (h)) * HTB)
#define PG8_SB(b, h) ((4 + (b) * 2 + (h)) * HTB)
#define PG8_STAGE(bufoff, gbase, voff) do { _Pragma("unroll") for (int _i = 0; _i < 2; ++_i) \
        GLDS16((const char*)(gbase) + (voff)[_i], lds + (bufoff) + ldsw + _i * 8192); } while (0)
#define PG8_LDA(dst, b, h) do { _Pragma("unroll") for (int m = 0; m < 4; ++m) _Pragma("unroll") for (int k = 0; k < 2; ++k) dst[m][k] = *(const PG8_LAS bf16x8*)(lds + PG8_SA(b, h) + aoff + m * 2048 + k * 1024); } while (0)
#define PG8_LDB(dst, b, h) do { _Pragma("unroll") for (int n = 0; n < 2; ++n) _Pragma("unroll") for (int k = 0; k < 2; ++k) dst[n][k] = *(const PG8_LAS bf16x8*)(lds + PG8_SB(b, h) + boff + n * 2048 + k * 1024); } while (0)
#define PG8_MMA(ai, bj, At, Bt) do { __builtin_amdgcn_s_setprio(1); _Pragma("unroll") for (int m = 0; m < 4; ++m) _Pragma("unroll") for (int n = 0; n < 2; ++n) _Pragma("unroll") for (int k = 0; k < 2; ++k) \
        acc[ai][bj][m][n] = __builtin_amdgcn_mfma_f32_16x16x32_bf16(Bt[n][k], At[m][k], acc[ai][bj][m][n], 0, 0, 0); __builtin_amdgcn_s_setprio(0); } while (0)
#define PG8_WAIT_V(n) ASM_WAIT("s_waitcnt vmcnt(" #n ")")
#define PG8_WAIT_L(n) ASM_WAIT("s_waitcnt lgkmcnt(" #n ")")
#define PG8_BAR __builtin_amdgcn_s_barrier()
#define PG8_SCHED __builtin_amdgcn_sched_barrier(0)
    Unit cur, nxt; int ui = 0;
    if (!S.next(0, cur)) return;
    f32x4 acc[2][2][4][2];
#pragma unroll
    for (int a = 0; a < 2; ++a)
#pragma unroll
        for (int b = 0; b < 2; ++b)
#pragma unroll
            for (int m = 0; m < 4; ++m)
#pragma unroll
                for (int n = 0; n < 2; ++n) acc[a][b][m][n] = (f32x4){0.f, 0.f, 0.f, 0.f};
    bf16x8 At[4][2], B0[2][2], B1[2][2];
    const char* cA = (const char*)g.A + (size_t)cur.pm * tstepA; const char* cB = (const char*)g.Bt + (size_t)cur.pn * tstepB;
    S.a_ready(cur);
    if constexpr (SP2) {
        PG8_STAGE(PG8_SB(0, 0), cB, voffB); PG8_STAGE(PG8_SB(0, 1), cB + hstepB, voffB); PG8_STAGE(PG8_SA(0, 0), cA, voffA); PG8_STAGE(PG8_SA(0, 1), cA + hstepA, voffA);
        if (wr == 1) PG8_BAR;
        PG8_WAIT_V(2); PG8_BAR;
        PG8_STAGE(PG8_SB(1, 0), cB + kstep, voffB); PG8_STAGE(PG8_SA(1, 0), cA + kstep, voffA); PG8_STAGE(PG8_SB(1, 1), cB + hstepB + kstep, voffB);
        PG8_WAIT_V(6); PG8_BAR;
    } else {
        PG8_STAGE(PG8_SB(0, 0), cB, voffB); PG8_STAGE(PG8_SA(0, 0), cA, voffA); PG8_STAGE(PG8_SB(0, 1), cB + hstepB, voffB); PG8_STAGE(PG8_SA(0, 1), cA + hstepA, voffA);
        if (wr == 1) PG8_BAR;
        PG8_WAIT_V(4); PG8_BAR;
        PG8_STAGE(PG8_SB(1, 0), cB + kstep, voffB); PG8_STAGE(PG8_SA(1, 0), cA + kstep, voffA); PG8_STAGE(PG8_SB(1, 1), cB + hstepB + kstep, voffB);
        PG8_WAIT_V(6); PG8_BAR;
    }
    for (;;) {
        const bool has_next = S.next(ui + 1, nxt);
        const char* nA = has_next ? (const char*)g.A + (size_t)nxt.pm * tstepA : cA; const char* nB = has_next ? (const char*)g.Bt + (size_t)nxt.pn * tstepB : cB;
        for (int t = 0; t < nt; t += 2) {
            const bool last = (t == nt - 2);
            const char* a1 = cA + (size_t)(t + 1) * kstep;
            const char* a2 = last ? nA : cA + (size_t)(t + 2) * kstep; const char* b2 = last ? nB : cB + (size_t)(t + 2) * kstep;
            const char* a3 = a2 + kstep; const char* b3 = b2 + kstep;
            if (last && has_next) S.a_ready(nxt);
            if constexpr (SP2) {
            PG8_LDB(B0, 0, 0); PG8_LDB(B1, 0, 1); PG8_SCHED; PG8_LDA(At, 0, 0); PG8_STAGE(PG8_SA(1, 1), a1 + hstepA, voffA);
            PG8_WAIT_V(8); PG8_WAIT_L(0); PG8_BAR; PG8_MMA(0, 0, At, B0); PG8_MMA(0, 1, At, B1); PG8_BAR; PG8_SCHED;
            PG8_LDA(At, 0, 1); PG8_STAGE(PG8_SB(0, 0), b2, voffB); PG8_STAGE(PG8_SB(0, 1), b2 + hstepB, voffB); PG8_STAGE(PG8_SA(0, 0), a2, voffA);
            PG8_WAIT_V(8); PG8_WAIT_L(0); PG8_BAR; PG8_MMA(1, 0, At, B0); PG8_MMA(1, 1, At, B1); PG8_BAR; PG8_SCHED;
            PG8_LDB(B0, 1, 0); PG8_LDB(B1, 1, 1); PG8_SCHED; PG8_LDA(At, 1, 0); PG8_STAGE(PG8_SA(0, 1), a2 + hstepA, voffA);
            PG8_WAIT_V(8); PG8_WAIT_L(0); PG8_BAR; PG8_MMA(0, 0, At, B0); PG8_MMA(0, 1, At, B1); PG8_BAR; PG8_SCHED;
            PG8_LDA(At, 1, 1); PG8_STAGE(PG8_SB(1, 0), b3, voffB); PG8_STAGE(PG8_SB(1, 1), b3 + hstepB, voffB); PG8_STAGE(PG8_SA(1, 0), a3, voffA);
            PG8_WAIT_V(8); PG8_WAIT_L(0); PG8_BAR; PG8_MMA(1, 0, At, B0); PG8_MMA(1, 1, At, B1); PG8_BAR; PG8_SCHED;
            } else {
            PG8_LDB(B0, 0, 0); PG8_SCHED; PG8_LDA(At, 0, 0); PG8_STAGE(PG8_SA(1, 1), a1 + hstepA, voffA);
            PG8_WAIT_L(8); PG8_BAR; PG8_WAIT_L(0); PG8_MMA(0, 0, At, B0); PG8_BAR; PG8_SCHED;
            PG8_LDB(B1, 0, 1); PG8_STAGE(PG8_SB(0, 0), b2, voffB);
            PG8_BAR; PG8_WAIT_L(0); PG8_MMA(0, 1, At, B1); PG8_BAR;
            PG8_LDA(At, 0, 1); PG8_STAGE(PG8_SA(0, 0), a2, voffA);
            PG8_BAR; PG8_WAIT_L(0); PG8_MMA(1, 0, At, B0); PG8_BAR; PG8_SCHED;
            PG8_STAGE(PG8_SB(0, 1), b2 + hstepB, voffB);
            PG8_WAIT_V(6); PG8_BAR; PG8_MMA(1, 1, At, B1); PG8_BAR;
            PG8_LDB(B0, 1, 0); PG8_SCHED; PG8_LDA(At, 1, 0); PG8_STAGE(PG8_SA(0, 1), a2 + hstepA, voffA);
            PG8_WAIT_L(8); PG8_BAR; PG8_WAIT_L(0); PG8_MMA(0, 0, At, B0); PG8_BAR; PG8_SCHED;
            PG8_LDB(B1, 1, 1); PG8_STAGE(PG8_SB(1, 0), b3, voffB);
            PG8_BAR; PG8_WAIT_L(0); PG8_MMA(0, 1, At, B1); PG8_BAR;
            PG8_LDA(At, 1, 1); PG8_STAGE(PG8_SA(1, 0), a3, voffA);
            PG8_BAR; PG8_WAIT_L(0); PG8_MMA(1, 0, At, B0); PG8_BAR; PG8_SCHED;
            PG8_STAGE(PG8_SB(1, 1), b3 + hstepB, voffB);
            PG8_WAIT_V(6); PG8_BAR; PG8_MMA(1, 1, At, B1); PG8_BAR;
            }
        }
        if constexpr (ALIGN_EPI) { if (wr == 0) PG8_BAR; }
        if constexpr (!Epi::AFTER_DRAIN) { E(acc, cur, wr, wc, fr, fq); S.done(cur); }
        if (!has_next) break;
#pragma unroll
        for (int a = 0; a < 2; ++a)
#pragma unroll
            for (int b = 0; b < 2; ++b)
#pragma unroll
                for (int m = 0; m < 4; ++m)
#pragma unroll
                    for (int n = 0; n < 2; ++n) acc[a][b][m][n] = (f32x4){0.f, 0.f, 0.f, 0.f};
        cur = nxt; cA = nA; cB = nB; ++ui;
        if constexpr (ALIGN_EPI) { if (wr == 1) PG8_BAR; }
    }
    PG8_WAIT_V(0);
    if constexpr (!ALIGN_EPI) { if (wr == 0) PG8_BAR; }
    PG8_BAR;
    if constexpr (Epi::AFTER_DRAIN) { E.fused(acc, cur, wr, wc, fr, fq, lds, wid, lane); S.done(cur); }
#undef PG8_SA
#undef PG8_SB
#undef PG8_STAGE
#undef PG8_LDA
#undef PG8_LDB
#undef PG8_MMA
#undef PG8_WAIT_V
#undef PG8_WAIT_L
#undef PG8_BAR
#undef PG8_SCHED
}
}
constexpr int RING_OFF = 0, RING_BYTES = 143360;
constexpr int LDSCTL_OFF = RING_BYTES, MISC_OFF = LDSCTL_OFF + 320;
constexpr int LDS_BYTES = 147456;
static_assert(MISC_OFF + 128 <= LDS_BYTES && pg8::STAGE_BYTES <= RING_BYTES, "LDS map");

typedef unsigned short bf16;
typedef unsigned v4u __attribute__((ext_vector_type(4)));
typedef unsigned v2u __attribute__((ext_vector_type(2)));
typedef float f32x4 __attribute__((ext_vector_type(4)));
typedef GAS unsigned gu32;
#define RLX_AGENT __ATOMIC_RELAXED, __HIP_MEMORY_SCOPE_AGENT
#define LDS_WAIT() ASM_WAIT("s_waitcnt lgkmcnt(0)")
#define VM_WAIT() ASM_WAIT("s_waitcnt vmcnt(0)")
#ifdef EMU
#define WAVE_SYNC() do { int _z = 0; (void)__shfl_xor(_z, 0); } while (0)
#else
#define WAVE_SYNC() do { asm volatile("s_waitcnt lgkmcnt(0)" ::: "memory"); __builtin_amdgcn_wave_barrier(); } while (0)
#endif
__device__ __forceinline__ unsigned f2bf(float f) { unsigned u = __float_as_uint(f); return (u + 0x7fffu + ((u >> 16) & 1u)) >> 16; }
__device__ __forceinline__ unsigned pk2(float lo, float hi) { return f2bf(lo) | (f2bf(hi) << 16); }
__device__ __forceinline__ float bflo(unsigned w) { return __uint_as_float(w << 16); }
__device__ __forceinline__ float bfhi(unsigned w) { return __uint_as_float(w & 0xffff0000u); }
__device__ __forceinline__ float bf2f(bf16 h) { return __uint_as_float((unsigned)h << 16); }

#define XB_TMO      128
#define XB_XCNT(j)  (256  + 64 * (j))
#define XB_XSUB(j)  (1280 + 64 * (j))
#define XB_XGEN(j)  (2304 + 64 * (j))
#define XB_TOP      3328
#define XB_TOPGEN   3392
#define XCD_BAR_WORDS 3456
#define XB_SPIN_CAP (1u << 18)

__device__ __forceinline__ unsigned xb_ld(unsigned* p)              { return __hip_atomic_load(p, __ATOMIC_RELAXED, __HIP_MEMORY_SCOPE_AGENT); }
__device__ __forceinline__ unsigned xb_add(unsigned* p, unsigned v) { return __hip_atomic_fetch_add(p, v, __ATOMIC_RELAXED, __HIP_MEMORY_SCOPE_AGENT); }
__device__ __forceinline__ unsigned xb_xcc_id() { return (unsigned)__builtin_amdgcn_s_getreg((3 << 11) | 20) & 0xFu; }
#define XB_SPIN(cond, bar) do { unsigned _sp = 0; while (cond) { __builtin_amdgcn_s_sleep(1); \
    if ((++_sp & 255u) == 0u) { if (xb_ld(&(bar)[XB_TMO])) break; if (_sp > XB_SPIN_CAP) { atomicAdd(&(bar)[XB_TMO], 1u); break; } } } } while (0)

struct XcdBarrier {
    unsigned* bar; unsigned x;
    volatile LAS unsigned* st;
};

__device__ __forceinline__ XcdBarrier xcd_barrier_post(unsigned* bar, volatile LAS unsigned* st) {
    XcdBarrier b; b.bar = bar; b.x = xb_xcc_id(); b.st = st;
    if (threadIdx.x == 0) (void)xb_add(&bar[XB_XCNT(b.x)], 1u);
    return b;
}
__device__ __forceinline__ void xcd_barrier_complete(unsigned* bar, unsigned x, unsigned& nloc, unsigned& nx) {
    const unsigned G = gridDim.x * gridDim.y * gridDim.z;
    unsigned sum, cnt, mine, sp = 0u;
    for (;;) {
        sum = 0u; cnt = 0u; mine = 0u;
#pragma unroll
        for (unsigned j = 0; j < 16; ++j) { const unsigned c = xb_ld(&bar[XB_XCNT(j)]); sum += c; cnt += (c > 0u) ? 1u : 0u; mine = (j == x) ? c : mine; }
        if (sum == G) break;
        __builtin_amdgcn_s_sleep(1);
        if ((++sp & 255u) == 0u) { if (xb_ld(&bar[XB_TMO])) break; if (sp > XB_SPIN_CAP) { atomicAdd(&bar[XB_TMO], 1u); break; } }
    }
    nloc = mine > 0u ? mine : 1u; nx = cnt > 0u ? cnt : 1u;
}

__device__ __forceinline__ void xcd_barrier(const XcdBarrier& b) {
    VM_WAIT();
    __syncthreads();
    if (threadIdx.x == 0) {
        unsigned* bar = b.bar;
        __builtin_amdgcn_s_waitcnt(0);
        unsigned nloc = b.st[0], nx = b.st[1];
        if (nloc == 0u) { xcd_barrier_complete(bar, b.x, nloc, nx); b.st[0] = nloc; b.st[1] = nx; }
        const unsigned old = xb_add(&bar[XB_XSUB(b.x)], 1u);
        const unsigned gen = old / nloc;
        if (old + 1u == (gen + 1u) * nloc) {
            __builtin_amdgcn_fence(__ATOMIC_RELEASE, "agent");
            VM_WAIT();
            const unsigned og = xb_add(&bar[XB_TOP], 1u);
            const unsigned tg = og / nx;
            if (og + 1u == (tg + 1u) * nx) xb_add(&bar[XB_TOPGEN], 1u);
            else XB_SPIN(xb_ld(&bar[XB_TOPGEN]) == tg, bar);
            __builtin_amdgcn_fence(__ATOMIC_ACQUIRE, "agent");
            xb_add(&bar[XB_XGEN(b.x)], 1u);
            VM_WAIT();
        } else {
            XB_SPIN(xb_ld(&bar[XB_XGEN(b.x)]) == gen, bar);
            __builtin_amdgcn_fence(__ATOMIC_ACQUIRE, "agent");
            VM_WAIT();
        }
    }
    __syncthreads();
}

struct Frame {
    LAS unsigned char* lds;
    volatile LAS unsigned* MISC;
    gu32* ctl;
    unsigned char* ws;
    int tid, lane, wave;
    int vcu, G;
};
__device__ __forceinline__ float wave_sum(float v) {
#pragma unroll
    for (int o = 1; o < 64; o <<= 1) v += __shfl_xor(v, o);
    return v;
}
__device__ __forceinline__ float wave_max(float v) {
#pragma unroll
    for (int o = 1; o < 64; o <<= 1) v = fmaxf(v, __shfl_xor(v, o));
    return v;
}
__device__ __forceinline__ void p0_transpose_item(const float* W, int N, bf16* WT, int ldt, int drow0, int kdst0, int k0, int n0, LAS float* scr, int lane) {
#pragma unroll 8
    for (int i = 0; i < 32; ++i) { const int kk = 2 * i + (lane >> 5); scr[kk * 33 + (lane & 31)] = W[(size_t)(k0 + kk) * N + n0 + (lane & 31)]; }
    WAVE_SYNC();
    const int c = lane & 7;
#pragma unroll
    for (int j = 0; j < 4; ++j) { const int n = (lane >> 3) + 8 * j; const LAS float* s = scr + (8 * c) * 33 + n;
        v4u o; o.x = pk2(s[0 * 33], s[1 * 33]); o.y = pk2(s[2 * 33], s[3 * 33]); o.z = pk2(s[4 * 33], s[5 * 33]); o.w = pk2(s[6 * 33], s[7 * 33]);
        *(v4u*)(WT + (size_t)(drow0 + n) * ldt + kdst0 + k0 + 8 * c) = o; }
    WAVE_SYNC();
}
__device__ __forceinline__ void p0_weights(Frame& F, const float* const* in, int l) {
    LAS float* scr = (LAS float*)(F.lds + RING_OFF + F.wave * 16384);
    const int gw = F.vcu * NWAVES + F.wave, NGW = F.G * NWAVES;
    bf16* WinT = (bf16*)(F.ws + WS_WIN); bf16* WmT = (bf16*)(F.ws + WS_WM); bf16* WoT = (bf16*)(F.ws + WS_WO); bf16* WguT = (bf16*)(F.ws + WS_WGU); bf16* WdT = (bf16*)(F.ws + WS_WD);
    const float* w_in = in[1] + (size_t)l * D * DIN; const float* w_ro = in[2] + (size_t)l * 2048 * D; const float* w_ao = in[3] + (size_t)l * 512 * D;
    const float* w_o = in[4] + (size_t)l * D * D; const float* w_g = in[5] + (size_t)l * D * DFF; const float* w_u = in[6] + (size_t)l * D * DFF; const float* w_d = in[7] + (size_t)l * DFF * D;
    constexpr int I_IN = (D / 64) * (DIN / 32), I_AO = (512 / 64) * (D / 32), I_RO = (2048 / 64) * (D / 32), I_O = (D / 64) * (D / 32), I_G = (D / 64) * (DFF / 32), I_D = (DFF / 64) * (D / 32);
    constexpr int NITEMS = I_IN + I_AO + I_RO + I_O + 2 * I_G + I_D;
    for (int it = gw; it < NITEMS; it += NGW) {
        int r = it;
        if (r < I_IN) { const int nb = r % (DIN / 32), kb = r / (DIN / 32), n0 = nb * 32;
            const int drow0 = (n0 >= 6144 && n0 < 10752) ? n0 - 6144 : (n0 < 6144 ? n0 + 4608 : n0);
            p0_transpose_item(w_in, DIN, WinT, D, drow0, 0, kb * 64, n0, scr, F.lane); continue; } r -= I_IN;
        if (r < I_AO) { const int nb = r % (D / 32), kb = r / (D / 32); p0_transpose_item(w_ao, D, WmT, 2560, nb * 32, 0, kb * 64, nb * 32, scr, F.lane); continue; } r -= I_AO;
        if (r < I_RO) { const int nb = r % (D / 32), kb = r / (D / 32); p0_transpose_item(w_ro, D, WmT, 2560, nb * 32, 512, kb * 64, nb * 32, scr, F.lane); continue; } r -= I_RO;
        if (r < I_O) { const int nb = r % (D / 32), kb = r / (D / 32); p0_transpose_item(w_o, D, WoT, D, nb * 32, 0, kb * 64, nb * 32, scr, F.lane); continue; } r -= I_O;
        if (r < 2 * I_G) { const int up = r >= I_G; if (up) r -= I_G; const int nb = r % (DFF / 32), kb = r / (DFF / 32), n0 = nb * 32;
            const int drow0 = (n0 >> 7) * 256 + (up ? 128 : 0) + (n0 & 127);
            p0_transpose_item(up ? w_u : w_g, DFF, WguT, D, drow0, 0, kb * 64, n0, scr, F.lane); continue; } r -= 2 * I_G;
        { const int nb = r % (D / 32), kb = r / (D / 32); p0_transpose_item(w_d, D, WdT, DFF, nb * 32, 0, kb * 64, nb * 32, scr, F.lane); }
    }
}
__device__ __forceinline__ void sincos_rr(float a, float& cs, float& sn) {
    const float k = rintf(a * 0.15915494309189535f);
    float r = fmaf(-k, 6.28125f, a); r = fmaf(-k, 1.9353071795864769e-3f, r); r = fmaf(-k, 2.5e-20f, r);
#ifdef EMU
    cs = cosf(r); sn = sinf(r);
#else
    cs = __cosf(r); sn = __sinf(r);
#endif
}
__device__ __forceinline__ void p0_tables(Frame& F) {
    float* tabR = (float*)(F.ws + WS_TABR); float* tabA = (float*)(F.ws + WS_TABA);
    const int gt = F.vcu * (NWAVES * 64) + F.tid, NT = F.G * NWAVES * 64;
    for (int i = gt; i < SEQ * 128; i += NT) { const int pos = i >> 7, d = i & 127; const float inv = powf(10000.0f, -(float)d / 128.0f); const float ang = (float)pos * inv;
        float cs, sn; sincos_rr(ang, cs, sn); tabR[i] = cs; tabR[(size_t)SEQ * 128 + i] = sn; }
    for (int i = gt; i < SEQ * 16; i += NT) { const int pos = i >> 4, d = i & 15; const float inv = powf(500000.0f, -(float)d / 16.0f); const float ang = (float)pos * inv;
        float cs, sn; sincos_rr(ang, cs, sn); tabA[i] = cs; tabA[(size_t)SEQ * 16 + i] = sn; }
}
__device__ __forceinline__ void rms_row_to_bf16(const float* xrow, const float* g, bf16* orow, int lane) {
    const f32x4* xr = (const f32x4*)xrow + lane; const f32x4* gr = (const f32x4*)g + lane;
    f32x4 v[4]; float s = 0.f;
#pragma unroll
    for (int j = 0; j < 4; ++j) { v[j] = xr[64 * j]; s += (v[j].x * v[j].x + v[j].y * v[j].y) + (v[j].z * v[j].z + v[j].w * v[j].w); }
    const float rstd = 1.0f / sqrtf(wave_sum(s) * (1.0f / D) + NORM_EPS);
    unsigned long long* o8 = (unsigned long long*)orow + lane;
#pragma unroll
    for (int j = 0; j < 4; ++j) { const f32x4 gg = gr[64 * j]; o8[64 * j] = (unsigned long long)pk2(v[j].x * rstd * gg.x, v[j].y * rstd * gg.y) | ((unsigned long long)pk2(v[j].z * rstd * gg.z, v[j].w * rstd * gg.w) << 32); }
}
__device__ __forceinline__ void p_norm_rows(Frame& F, const float* X, const float* g, bf16* XN) {
    const int gw = F.vcu * NWAVES + F.wave, NGW = F.G * NWAVES;
    for (int m = gw; m < M; m += NGW) rms_row_to_bf16(X + (size_t)m * D, g, XN + (size_t)m * D, F.lane);
}
__device__ __forceinline__ void p_resid_rows(Frame& F, const float* Y, const float* Xi, float* Xo, const float* g1, const float* g2, bf16* XN) {
    const int gw = F.vcu * NWAVES + F.wave, NGW = F.G * NWAVES, lane = F.lane;
    for (int m = gw; m < M; m += NGW) {
        const f32x4* yr = (const f32x4*)(Y + (size_t)m * D) + lane; const f32x4* xr = (const f32x4*)(Xi + (size_t)m * D) + lane; f32x4* xo = (f32x4*)(Xo + (size_t)m * D) + lane;
        f32x4 v[4], x[4]; float s = 0.f;
#pragma unroll
        for (int j = 0; j < 4; ++j) { v[j] = yr[64 * j]; x[j] = xr[64 * j]; s += (v[j].x * v[j].x + v[j].y * v[j].y) + (v[j].z * v[j].z + v[j].w * v[j].w); }
        const float rstd = 1.0f / sqrtf(wave_sum(s) * (1.0f / D) + NORM_EPS); float s2 = 0.f;
#pragma unroll
        for (int j = 0; j < 4; ++j) { const f32x4 gg = ((const f32x4*)g1 + lane)[64 * j]; x[j] = x[j] + v[j] * rstd * gg; xo[64 * j] = x[j]; s2 += (x[j].x * x[j].x + x[j].y * x[j].y) + (x[j].z * x[j].z + x[j].w * x[j].w); }
        if (g2) { const float r2 = 1.0f / sqrtf(wave_sum(s2) * (1.0f / D) + NORM_EPS); unsigned long long* o8 = (unsigned long long*)(XN + (size_t)m * D) + lane;
#pragma unroll
            for (int j = 0; j < 4; ++j) { const f32x4 gg = ((const f32x4*)g2 + lane)[64 * j]; o8[64 * j] = (unsigned long long)pk2(x[j].x * r2 * gg.x, x[j].y * r2 * gg.y) | ((unsigned long long)pk2(x[j].z * r2 * gg.z, x[j].w * r2 * gg.w) << 32); } }
    }
}

__device__ __forceinline__ void att_unit_scalar(Frame& F, int u) {
    bf16* AQ = (bf16*)(F.ws + WS_ACT + A_AQ); const bf16* AK = (const bf16*)(F.ws + WS_ACT + A_AK); const bf16* AV = (const bf16*)(F.ws + WS_ACT + A_AV); float* LSE = (float*)(F.ws + WS_LSE);
    const int b = u / (12 * NBLK), rem = u % (12 * NBLK), gi = rem / (4 * NBLK), rem2 = rem % (4 * NBLK), j = rem2 / NBLK, blk = rem2 % NBLK;
    const int r = gi == 0 ? 1 : (gi == 1 ? 4 : 16), nb = NBLK / r, p = blk / nb, n = blk % nb, head = gi * 4 + j;
    LAS bf16* Kl = (LAS bf16*)(F.lds);
    LAS bf16* Vl = (LAS bf16*)(F.lds + 66560);
    LAS float* qs = (LAS float*)(F.lds + 66560 + 65536) + F.wave * 128;
    LAS float* ps = (LAS float*)(F.lds + 66560 + 65536 + 4096) + F.wave * 132;
    for (int idx = F.tid; idx < 256 * 16; idx += NWAVES * 64) {
        const int m = idx >> 4, ch = idx & 15; const int ti = 128 * (n - 1) + m;
        v4u kv = {0u, 0u, 0u, 0u}, vv = {0u, 0u, 0u, 0u};
        if (ti >= 0) { const size_t off = ((size_t)b * SEQ + p + (size_t)r * ti) * 1536 + head * 128 + ch * 8; kv = *(const v4u*)(AK + off); vv = *(const v4u*)(AV + off); }
        LAS unsigned* kd = (LAS unsigned*)(Kl + m * 130 + ch * 8); kd[0] = kv.x; kd[1] = kv.y; kd[2] = kv.z; kd[3] = kv.w;
        *(LAS v4u*)(Vl + m * 128 + ch * 8) = vv;
    }
    __syncthreads();
    const int lane = F.lane;
    for (int i = 0; i < 16; ++i) {
        const int c = F.wave * 16 + i; const size_t tok = (size_t)b * SEQ + p + (size_t)r * (128 * n + c);
        bf16* qrow = AQ + tok * 1536 + head * 128;
        { const unsigned w = *(const unsigned*)(qrow + 2 * lane); qs[2 * lane] = bflo(w); qs[2 * lane + 1] = bfhi(w); }
        WAVE_SYNC();
        float sc[3]; float mx = -3.0e38f;
#pragma unroll
        for (int kk = 0; kk < 3; ++kk) {
            const int mrel = lane + 64 * kk, m = c + mrel; const bool valid = (mrel <= 128) && (n > 0 || m >= 128);
            float s = 0.f;
            if (valid) { const LAS unsigned* kr = (const LAS unsigned*)(Kl + m * 130);
                for (int d2 = 0; d2 < 64; ++d2) { const unsigned w = kr[d2]; s += qs[2 * d2] * bflo(w) + qs[2 * d2 + 1] * bfhi(w); } }
            sc[kk] = valid ? s : -3.0e38f; mx = fmaxf(mx, sc[kk]);
        }
        mx = wave_max(mx);
        float sum = 0.f;
#pragma unroll
        for (int kk = 0; kk < 3; ++kk) { const float e = sc[kk] > -1.0e38f ? __expf(sc[kk] - mx) : 0.f; sum += e; if (lane + 64 * kk < 132) ps[lane + 64 * kk] = e; }
        sum = wave_sum(sum);
        WAVE_SYNC();
        float o0 = 0.f, o1 = 0.f;
        for (int mrel = 0; mrel <= 128; ++mrel) { const float pw = ps[mrel]; const unsigned w = *(const LAS unsigned*)(Vl + (c + mrel) * 128 + 2 * lane); o0 += pw * bflo(w); o1 += pw * bfhi(w); }
        const float inv = 1.0f / sum;
        *(unsigned*)(qrow + 2 * lane) = pk2(o0 * inv, o1 * inv);
        if (lane == 0) LSE[((size_t)gi * M + tok) * 4 + j] = mx + __logf(sum);
        WAVE_SYNC();
    }
    __syncthreads();
}
__device__ __forceinline__ void p_att_merge(Frame& F) {
    const bf16* AQ = (const bf16*)(F.ws + WS_ACT + A_AQ); bf16* AR = (bf16*)(F.ws + WS_ACT + A_AR); const float* LSE = (const float*)(F.ws + WS_LSE);
    const int gw = F.vcu * NWAVES + F.wave, NGW = F.G * NWAVES, lane = F.lane, j = lane >> 4, d0 = (lane & 15) * 8;
    for (int t = gw; t < M; t += NGW) {
        float l[3]; float mx = -3.0e38f;
#pragma unroll
        for (int g = 0; g < 3; ++g) { l[g] = LSE[((size_t)g * M + t) * 4 + j]; mx = fmaxf(mx, l[g]); }
        float w[3]; float ws_ = 0.f;
#pragma unroll
        for (int g = 0; g < 3; ++g) { w[g] = __expf(l[g] - mx); ws_ += w[g]; }
        const float inv = 1.0f / ws_;
        float o[8] = {0.f, 0.f, 0.f, 0.f, 0.f, 0.f, 0.f, 0.f};
#pragma unroll
        for (int g = 0; g < 3; ++g) { const v4u q = *(const v4u*)(AQ + (size_t)t * 1536 + (g * 4 + j) * 128 + d0); const float wg = w[g] * inv;
            o[0] += wg * bflo(q.x); o[1] += wg * bfhi(q.x); o[2] += wg * bflo(q.y); o[3] += wg * bfhi(q.y); o[4] += wg * bflo(q.z); o[5] += wg * bfhi(q.z); o[6] += wg * bflo(q.w); o[7] += wg * bfhi(q.w); }
        v4u ov; ov.x = pk2(o[0], o[1]); ov.y = pk2(o[2], o[3]); ov.z = pk2(o[4], o[5]); ov.w = pk2(o[6], o[7]);
        *(v4u*)(AR + (size_t)t * 2560 + j * 128 + d0) = ov;
    }
}

struct RetConst { float lg, a, a8; };
__device__ __forceinline__ RetConst ret_const(int h) { RetConst c; c.lg = logf(1.0f - exp2f(-5.0f - (float)h)); c.a = expf(128.0f * c.lg); c.a8 = expf(1024.0f * c.lg); return c; }
__device__ __forceinline__ void ret_pass1_scalar(Frame& F, int ur) {
    const bf16* RK = (const bf16*)(F.ws + WS_ACT + A_RK); const bf16* RV = (const bf16*)(F.ws + WS_ACT + A_RV); float* FS = (float*)(F.ws + WS_ACT + A_F);
    const int g = ur % NSEG, s = (ur / NSEG) & 3, h = (ur / (NSEG * 4)) & 3, b = ur / (NSEG * 16);
    const RetConst rc = ret_const(h);
    const int dv = F.tid & 127, dkg = F.tid >> 7;
    float R[64];
#pragma unroll
    for (int jj = 0; jj < 64; ++jj) R[jj] = 0.f;
    for (int i = 0; i < 8; ++i) {
        const size_t tb = (size_t)b * SEQ + (size_t)(g * 8 + i) * 128;
#pragma unroll
        for (int jj = 0; jj < 64; ++jj) R[jj] *= rc.a;
        for (int c = 0; c < 128; ++c) {
            const float v = bf2f(RV[(tb + c) * 2048 + h * 512 + s * 128 + dv]) * expf((float)(127 - c) * rc.lg);
            const v4u* kp = (const v4u*)(RK + (tb + c) * 1024 + h * 256 + dkg * 64);
#pragma unroll
            for (int q = 0; q < 8; ++q) { const v4u k = kp[q];
                R[8 * q + 0] += bflo(k.x) * v; R[8 * q + 1] += bfhi(k.x) * v; R[8 * q + 2] += bflo(k.y) * v; R[8 * q + 3] += bfhi(k.y) * v;
                R[8 * q + 4] += bflo(k.z) * v; R[8 * q + 5] += bfhi(k.z) * v; R[8 * q + 6] += bflo(k.w) * v; R[8 * q + 7] += bfhi(k.w) * v; }
        }
    }
    float* fo = FS + (size_t)ur * 32768;
#pragma unroll
    for (int jj = 0; jj < 64; ++jj) fo[(dkg * 64 + jj) * 128 + dv] = R[jj];
}
__device__ __forceinline__ void ret_pass2_scalar(Frame& F, int ur) {
    const bf16* RQ = (const bf16*)(F.ws + WS_ACT + A_RQ); const bf16* RK = (const bf16*)(F.ws + WS_ACT + A_RK); bf16* RV = (bf16*)(F.ws + WS_ACT + A_RV); const float* FS = (const float*)(F.ws + WS_ACT + A_F);
    const int g = ur % NSEG, s = (ur / NSEG) & 3, h = (ur / (NSEG * 4)) & 3, b = ur / (NSEG * 16);
    const RetConst rc = ret_const(h);
    const int tid = F.tid, dv = tid & 127, dkg = tid >> 7;
    LAS bf16* Rl = (LAS bf16*)(F.lds);
    LAS bf16* Sl = (LAS bf16*)(F.lds + 65536);
    LAS bf16* Vl = (LAS bf16*)(F.lds + 65536 + 32768);
    float R[64];
#pragma unroll
    for (int jj = 0; jj < 64; ++jj) R[jj] = 0.f;
    for (int gp = 0; gp < g; ++gp) { const float wgt = expf((float)(1024 * (g - 1 - gp)) * rc.lg); const float* fi = FS + (size_t)(ur - g + gp) * 32768;
#pragma unroll
        for (int jj = 0; jj < 64; ++jj) R[jj] += wgt * fi[(dkg * 64 + jj) * 128 + dv]; }
    for (int i = 0; i < 8; ++i) {
        const size_t tb = (size_t)b * SEQ + (size_t)(g * 8 + i) * 128;
#pragma unroll
        for (int jj = 0; jj < 64; ++jj) Rl[(dkg * 64 + jj) * 128 + dv] = (bf16)f2bf(R[jj]);
        for (int e = tid; e < 128 * 128; e += NWAVES * 64) { const int c = e >> 7;  Vl[e] = RV[(tb + c) * 2048 + h * 512 + s * 128 + (e & 127)]; }
        for (int e = tid; e < 128 * 128; e += NWAVES * 64) { const int c = e >> 7, cp = e & 127; float sv = 0.f;
            if (cp <= c) { const v4u* qp = (const v4u*)(RQ + (tb + c) * 1024 + h * 256); const v4u* kp = (const v4u*)(RK + (tb + cp) * 1024 + h * 256);
                for (int q = 0; q < 32; ++q) { const v4u a = qp[q], k = kp[q];
                    sv += bflo(a.x) * bflo(k.x) + bfhi(a.x) * bfhi(k.x) + bflo(a.y) * bflo(k.y) + bfhi(a.y) * bfhi(k.y) + bflo(a.z) * bflo(k.z) + bfhi(a.z) * bfhi(k.z) + bflo(a.w) * bflo(k.w) + bfhi(a.w) * bfhi(k.w); }
                sv *= expf((float)(c - cp) * rc.lg); }
            Sl[e] = (bf16)f2bf(sv); }
        __syncthreads();
        for (int ci = 0; ci < 32; ++ci) { const int c = dkg * 32 + ci; float cross = 0.f, intra = 0.f;
            const v4u* qp = (const v4u*)(RQ + (tb + c) * 1024 + h * 256);
            for (int q = 0; q < 32; ++q) { const v4u a = qp[q]; const LAS bf16* rp = Rl + (8 * q) * 128 + dv;
                cross += bflo(a.x) * bf2f(rp[0]) + bfhi(a.x) * bf2f(rp[128]) + bflo(a.y) * bf2f(rp[256]) + bfhi(a.y) * bf2f(rp[384]) + bflo(a.z) * bf2f(rp[512]) + bfhi(a.z) * bf2f(rp[640]) + bflo(a.w) * bf2f(rp[768]) + bfhi(a.w) * bf2f(rp[896]); }
            for (int cp = 0; cp <= c; ++cp) intra += bf2f(Sl[c * 128 + cp]) * bf2f(Vl[cp * 128 + dv]);
            const float y = expf((float)(c + 1) * rc.lg) * cross + intra;
            RV[(tb + c) * 2048 + h * 512 + s * 128 + dv] = (bf16)f2bf(y); }
#pragma unroll
        for (int jj = 0; jj < 64; ++jj) R[jj] *= rc.a;
        for (int c = 0; c < 128; ++c) {
            const float v = bf2f(Vl[c * 128 + dv]) * expf((float)(127 - c) * rc.lg);
            const v4u* kp = (const v4u*)(RK + (tb + c) * 1024 + h * 256 + dkg * 64);
#pragma unroll
            for (int q = 0; q < 8; ++q) { const v4u k = kp[q];
                R[8 * q + 0] += bflo(k.x) * v; R[8 * q + 1] += bfhi(k.x) * v; R[8 * q + 2] += bflo(k.y) * v; R[8 * q + 3] += bfhi(k.y) * v;
                R[8 * q + 4] += bflo(k.z) * v; R[8 * q + 5] += bfhi(k.z) * v; R[8 * q + 6] += bflo(k.w) * v; R[8 * q + 7] += bfhi(k.w) * v; }
        }
        __syncthreads();
    }
}
__device__ __forceinline__ void p_ret_finalize(Frame& F) {
    const bf16* Y = (const bf16*)(F.ws + WS_ACT + A_RV); bf16* AR = (bf16*)(F.ws + WS_ACT + A_AR);
    const int gw = F.vcu * NWAVES + F.wave, NGW = F.G * NWAVES, lane = F.lane;
    for (int rr = gw; rr < M * 4; rr += NGW) { const int t = rr >> 2, h = rr & 3;
        const v4u q = *(const v4u*)(Y + (size_t)t * 2048 + h * 512 + lane * 8);
        float y[8] = {bflo(q.x), bfhi(q.x), bflo(q.y), bfhi(q.y), bflo(q.z), bfhi(q.z), bflo(q.w), bfhi(q.w)};
        float s = 0.f;
#pragma unroll
        for (int e = 0; e < 8; ++e) s += y[e];
        const float mu = wave_sum(s) * (1.0f / 512.0f); float s2 = 0.f;
#pragma unroll
        for (int e = 0; e < 8; ++e) { y[e] -= mu; s2 += y[e] * y[e]; }
        const float rstd = 1.0f / sqrtf(wave_sum(s2) * (1.0f / 512.0f) + NORM_EPS);
        bf16* ap = AR + (size_t)t * 2560 + 512 + h * 512 + lane * 8; const v4u gq = *(const v4u*)ap;
        v4u o; o.x = pk2(bflo(gq.x) * y[0] * rstd, bfhi(gq.x) * y[1] * rstd); o.y = pk2(bflo(gq.y) * y[2] * rstd, bfhi(gq.y) * y[3] * rstd);
        o.z = pk2(bflo(gq.z) * y[4] * rstd, bfhi(gq.z) * y[5] * rstd); o.w = pk2(bflo(gq.w) * y[6] * rstd, bfhi(gq.w) * y[7] * rstd);
        *(v4u*)ap = o; }
}

constexpr int N_PHASES = 1 + 14 * DEPTH;
struct Args { const float* in[12]; float* out; unsigned char* ws; int ph_lo, ph_hi, li, pad; };
__global__ void __launch_bounds__(NWAVES * 64, 2) mk_fwd(Args args) {
#ifdef EMU
    unsigned char* lds = EMU_LDS_PTR;
#else
    extern __shared__ __attribute__((aligned(16))) unsigned char lds[];
#endif
    Frame F;
    F.lds = (LAS unsigned char*)lds;
    F.MISC = (volatile LAS unsigned*)(F.lds + MISC_OFF);
    F.tid = threadIdx.x; F.lane = F.tid & 63; F.wave = __builtin_amdgcn_readfirstlane(F.tid >> 6);
    F.G = gridDim.x; { const int bx = blockIdx.x; F.vcu = (F.G % 8 == 0) ? (bx % 8) * (F.G / 8) + bx / 8 : bx; }
    F.ws = args.ws; F.ctl = (gu32*)(args.ws + WS_CTL);
    for (int u = F.tid; u < (LDS_BYTES - LDSCTL_OFF) / 4; u += NWAVES * 64) ((LAS unsigned*)(F.lds + LDSCTL_OFF))[u] = 0u;
    __syncthreads();
    const bool one_launch = (MK_N_LAUNCHES == 1);
    XcdBarrier bar; bar.bar = (unsigned*)(F.ctl + CW_BAR); bar.x = 0; bar.st = nullptr;
    if (one_launch) bar = xcd_barrier_post((unsigned*)(F.ctl + CW_BAR), F.MISC + 8);
    const int lo = args.ph_lo, hi = args.ph_hi;
    unsigned char* act = F.ws + WS_ACT;
    bf16* XN = (bf16*)(F.ws + WS_XN);
    const bf16* WinT = (const bf16*)(F.ws + WS_WIN); const bf16* WmT = (const bf16*)(F.ws + WS_WM); const bf16* WoT = (const bf16*)(F.ws + WS_WO); const bf16* WguT = (const bf16*)(F.ws + WS_WGU); const bf16* WdT = (const bf16*)(F.ws + WS_WD);

#ifndef DIS
#define DIS 0
#endif
#define PH(k) (lo <= (k) && (k) < hi)
#define EN(k) (!((DIS >> (k)) & 1))
#ifdef EMU
#define REFRESH() ((void)0)
#else
#define REFRESH() do { int t_ = threadIdx.x; asm volatile("" : "+v"(t_)); F.tid = t_; F.lane = t_ & 63; F.wave = __builtin_amdgcn_readfirstlane(t_ >> 6); \
    unsigned char* w_ = args.ws; asm volatile("" : "+s"(w_)); F.ws = w_; F.ctl = (gu32*)(w_ + WS_CTL); act = w_ + WS_ACT; XN = (bf16*)(w_ + WS_XN); \
    WinT = (const bf16*)(w_ + WS_WIN); WmT = (const bf16*)(w_ + WS_WM); WoT = (const bf16*)(w_ + WS_WO); WguT = (const bf16*)(w_ + WS_WGU); WdT = (const bf16*)(w_ + WS_WD); } while (0)
#endif
#define SEAM(k) do { if (one_launch && PH(k) && PH((k) + 1)) xcd_barrier(bar); } while (0)
    if (PH(0)) { REFRESH(); if (EN(14)) p0_weights(F, args.in, 0); p0_tables(F); p_norm_rows(F, args.in[0], args.in[8], XN); }
    SEAM(0);
#pragma unroll
    for (int l = 0; l < DEPTH; ++l) {
        const int pb = 1 + 14 * l;
        if (PH(pb + 0) && EN(0)) { REFRESH(); { pg8::Gemm g{XN, WinT, M, NATT, D, D, D}; pg8::StaticOrder S; S.init(M, NATT, F.G, (int)blockIdx.x);
            pg8::EpiAtt E{(bf16*)(act + A_AQ), (A_AK - A_AQ) / 2, (const float*)(F.ws + WS_TABA)};
            pg8::gemm_phase<pg8::EpiAtt, pg8::StaticOrder, true, true>(F.lds + RING_OFF, g, S, E); }
        }
        SEAM(pb + 0);
        if (PH(pb + 1) && EN(1)) { REFRESH(); { for (int u = F.vcu; u < NAU; u += F.G) att_unit_scalar(F, u); }
        }
        SEAM(pb + 1);
        if (PH(pb + 2) && EN(2)) { REFRESH(); p_att_merge(F);
        }
        SEAM(pb + 2);
        if (PH(pb + 3) && EN(3)) { REFRESH(); { pg8::Gemm g{XN, WinT + (size_t)NATT * D, M, NRET, D, D, D}; pg8::StaticOrder S; S.init(M, NRET, F.G, (int)blockIdx.x);
            pg8::EpiRet E{(bf16*)act, (const float*)(F.ws + WS_TABR)};
            pg8::gemm_phase<pg8::EpiRet, pg8::StaticOrder, true, true>(F.lds + RING_OFF, g, S, E); }
        }
        SEAM(pb + 3);
        if (PH(pb + 4) && EN(4)) { REFRESH(); { for (int u = F.vcu; u < NRU; u += F.G) ret_pass1_scalar(F, u); }
        }
        SEAM(pb + 4);
        if (PH(pb + 5) && EN(5)) { REFRESH(); { for (int u = F.vcu; u < NRU; u += F.G) ret_pass2_scalar(F, u); }
        }
        SEAM(pb + 5);
        if (PH(pb + 6) && EN(6)) { REFRESH(); p_ret_finalize(F);
        }
        SEAM(pb + 6);
        if (PH(pb + 7) && EN(7)) { REFRESH(); { pg8::Gemm g{(const bf16*)(act + A_AR), WmT, M, D, 512, 2560, 2560}; pg8::StaticOrder S; S.init(M, D, F.G, (int)blockIdx.x);
            pg8::EpiGate E{(float*)(act + A_T), nullptr, D, (const bf16*)(act + A_GA), D, nullptr, 0};
            pg8::gemm_phase<pg8::EpiGate, pg8::StaticOrder, true, true>(F.lds + RING_OFF, g, S, E); }
        }
        SEAM(pb + 7);
        if (PH(pb + 8) && EN(8)) { REFRESH(); { pg8::Gemm g{(const bf16*)(act + A_AR) + 512, WmT + 512, M, D, 2048, 2560, 2560}; pg8::StaticOrder S; S.init(M, D, F.G, (int)blockIdx.x);
            pg8::EpiGate E{nullptr, (bf16*)(act + A_MG), D, (const bf16*)(act + A_GR), D, (const float*)(act + A_T), D};
            pg8::gemm_phase<pg8::EpiGate, pg8::StaticOrder, true, true>(F.lds + RING_OFF, g, S, E); }
        }
        SEAM(pb + 8);
        if (PH(pb + 9) && EN(9)) { REFRESH(); { pg8::Gemm g{(const bf16*)(act + A_MG), WoT, M, D, D, D, D}; pg8::StaticOrder S; S.init(M, D, F.G, (int)blockIdx.x);
            pg8::EpiGate E{(float*)(act + A_M32), nullptr, D, nullptr, 0, nullptr, 0};
            pg8::gemm_phase<pg8::EpiGate, pg8::StaticOrder, true, true>(F.lds + RING_OFF, g, S, E); }
        }
        SEAM(pb + 9);
        if (PH(pb + 10) && EN(10)) { REFRESH(); p_resid_rows(F, (const float*)(act + A_M32), l == 0 ? args.in[0] : args.out, args.out, args.in[9] + (size_t)l * D, args.in[10] + (size_t)l * D, XN);
        }
        SEAM(pb + 10);
        if (PH(pb + 11) && EN(11)) { REFRESH(); { pg8::Gemm g{XN, WguT, M, 2 * DFF, D, D, D}; pg8::StaticOrder S; S.init(M, 2 * DFF, F.G, (int)blockIdx.x);
            pg8::EpiSwiGLU E{(bf16*)(act + A_ACT), DFF};
            pg8::gemm_phase<pg8::EpiSwiGLU, pg8::StaticOrder, true, true>(F.lds + RING_OFF, g, S, E); }
        }
        SEAM(pb + 11);
        if (PH(pb + 12) && EN(12)) { REFRESH(); { pg8::Gemm g{(const bf16*)(act + A_ACT), WdT, M, D, DFF, DFF, DFF}; pg8::StaticOrder S; S.init(M, D, F.G, (int)blockIdx.x);
            pg8::EpiGate E{(float*)(act + A_F32), nullptr, D, nullptr, 0, nullptr, 0};
            pg8::gemm_phase<pg8::EpiGate, pg8::StaticOrder, true, true>(F.lds + RING_OFF, g, S, E); }
        }
        SEAM(pb + 12);
        if (PH(pb + 13) && EN(13)) { REFRESH(); { const bool more = (l + 1 < DEPTH);
            p_resid_rows(F, (const float*)(act + A_F32), args.out, args.out, args.in[11] + (size_t)l * D, more ? args.in[8] + (size_t)(l + 1) * D : nullptr, XN);
            if (more) p0_weights(F, args.in, l + 1); }
        }
        SEAM(pb + 13);
    }
}

extern "C" void kernel_launch(void* const* d_in, const int* in_sizes, int n_in, void* d_out, int out_size, void* d_ws, size_t ws_size, hipStream_t stream) {
    static int grid = 0;
    if (grid == 0) {
        if (n_in != 12 || in_sizes[0] != M * D || out_size != M * D || ws_size < WS_END) { fprintf(stderr, "kernel_launch: unexpected shapes (n_in %d, in0 %d, out %d, ws %zu need %zu); nothing launched\n", n_in, n_in > 0 ? in_sizes[0] : -1, out_size, ws_size, (size_t)WS_END); grid = -1; return; }
        int dev = 0, cus = 0, per_cu = 0;
        if (hipGetDevice(&dev) != hipSuccess || hipDeviceGetAttribute(&cus, hipDeviceAttributeMultiprocessorCount, dev) != hipSuccess) { grid = -1; return; }
        if (hipFuncSetAttribute((const void*)mk_fwd, hipFuncAttributeMaxDynamicSharedMemorySize, LDS_BYTES) != hipSuccess) { fprintf(stderr, "kernel_launch: hipFuncSetAttribute failed\n"); grid = -1; return; }
        if (hipOccupancyMaxActiveBlocksPerMultiprocessor(&per_cu, (const void*)mk_fwd, NWAVES * 64, LDS_BYTES) != hipSuccess || per_cu < 1) fprintf(stderr, "kernel_launch: occupancy query reports %d\n", per_cu);
        (void)hipGetLastError();
        grid = cus;
    }
    if (grid < 0) return;
    if (hipMemsetAsync((char*)d_ws + WS_CTL, 0, CTL_ZERO_BYTES, stream) != hipSuccess) return;
    Args a{};
    for (int i = 0; i < 12; ++i) a.in[i] = (const float*)d_in[i];
    a.out = (float*)d_out; a.ws = (unsigned char*)d_ws;
    if (MK_N_LAUNCHES == 1) { a.ph_lo = 0; a.ph_hi = N_PHASES; a.li = 0; hipLaunchKernelGGL(mk_fwd, dim3(grid), dim3(NWAVES * 64), LDS_BYTES, stream, a); }
    else for (int ph = 0; ph < N_PHASES; ++ph) { a.ph_lo = ph; a.ph_hi = ph + 1; a.li = ph; hipLaunchKernelGGL(mk_fwd, dim3(grid), dim3(NWAVES * 64), LDS_BYTES, stream, a); }
}
```

```cpp
#ifdef EMU
#include "emu.h"
#else
#include <hip/hip_runtime.h>
#endif
#include <cstdio>
#include <cstdint>
#include <cmath>

#ifndef CFG_BATCH
#define CFG_BATCH 2
#endif
#ifndef CFG_SEQ
#define CFG_SEQ 8192
#endif
#ifndef MK_N_LAUNCHES
#define MK_N_LAUNCHES 1
#endif

#ifdef EMU
#define PG8_LAS
#define GAS
#define LAS
#define ASM_WAIT(s) ((void)0)
#define OPAQUE_V(x) ((void)0)
#define GLDS16(gp, lp) emu_global_load_lds16((const void*)(gp), (void*)(lp))
#else
#define PG8_LAS __attribute__((address_space(3)))
#define GAS __attribute__((address_space(1)))
#define LAS __attribute__((address_space(3)))
#define ASM_WAIT(s) asm volatile(s ::: "memory")
#define OPAQUE_V(x) asm volatile("" : "+v"(x))
#define GLDS16(gp, lp) __builtin_amdgcn_global_load_lds((const unsigned*)(gp), (PG8_LAS unsigned*)(lp), 16, 0, 0)
#endif

constexpr int NWAVES = 8;
constexpr int BATCH = CFG_BATCH, SEQ = CFG_SEQ, D = 1024, M = BATCH * SEQ;
constexpr int DIN = 12800, NATT = 4608, NRET = 8192, DFF = 2816, DEPTH = 2;
constexpr int NSEG = SEQ / 1024;
constexpr int NRU = BATCH * 4 * 4 * NSEG;
constexpr int NBLK = SEQ / 128;
constexpr int NAU = BATCH * 12 * NBLK;
constexpr float NORM_EPS = 1e-6f;
static_assert(SEQ % 2048 == 0 && M % 256 == 0, "shape");

constexpr size_t MiB = 1u << 20;
constexpr size_t WS_CTL = 0, CTL_ZERO_BYTES = 1 * MiB;
constexpr size_t WS_WIN = 1 * MiB, WS_WM = 26 * MiB, WS_WO = 31 * MiB, WS_WGU = 33 * MiB, WS_WD = 44 * MiB;
constexpr size_t WS_TABR = 50 * MiB, WS_TABA = 58 * MiB, WS_LSE = 59 * MiB, WS_XN = 60 * MiB, WS_ACT = 92 * MiB;
constexpr size_t RB = (size_t)M * 2048;
constexpr size_t A_AQ = 0, A_AK = RB * 3 / 2, A_AV = RB * 3;
constexpr size_t A_RQ = 0, A_RK = RB, A_RV = 2 * RB, A_AR = 4 * RB, A_GR = RB * 13 / 2, A_GA = RB * 15 / 2, A_F = RB * 17 / 2;
constexpr size_t A_T = 0, A_MG = 2 * RB, A_M32 = 0, A_ACT = 3 * RB, A_F32 = 0;
constexpr size_t WS_END = WS_ACT + RB * 19 / 2;
static_assert(A_AV - A_AK == A_AK - A_AQ && WS_END <= 400 * MiB, "d_ws map");
static_assert((size_t)SEQ * 128 * 4 * 2 <= 8 * MiB && (size_t)3 * M * 4 * 4 <= MiB && (size_t)M * D * 2 <= 32 * MiB, "d_ws map");
constexpr int CW_TMO = 0, CW_CODE = 1, CW_BAR = 4096;

namespace pg8 {
typedef unsigned short bf16_t;
typedef short bf16x8 __attribute__((ext_vector_type(8)));
typedef float f32x4 __attribute__((ext_vector_type(4)));
typedef unsigned u32x4 __attribute__((ext_vector_type(4)));
constexpr int BM = 256, BK = 64, HALF = 128, HTB = HALF * BK * 2  , STAGE_BYTES = 8 * HTB, NXCD = 8, WGM = 8;

__host__ __device__ __forceinline__ int lds_byte(int r, int c) { const int st = (r >> 4) * 2 + (c >> 5), rr = r & 15, cc = c & 31, ob = rr * 64 + cc * 2; return st * 1024 + (ob ^ (((ob >> 9) & 1) << 5)); }
__host__ __device__ __forceinline__ void stage_rc(int b, int& R, int& C) { const int st = b / 1024, sb = b % 1024, swz = sb ^ (((sb >> 9) & 1) << 5); R = (st >> 1) * 16 + swz / 64; C = (st & 1) * 32 + (swz % 64) / 2; }
__host__ __device__ __forceinline__ int perm32(int rho) { const int n = rho >> 4, i = rho & 15; return 8 * (i >> 2) + 4 * n + (i & 3); }

struct Unit { int pm, pn; };
struct Gemm { const bf16_t* A; const bf16_t* Bt; int M, N, K, lda, ldb; };

struct StaticOrder {
    int nM, nN, nwg, G, c;
    __host__ __device__ void init(int M, int N, int G_, int c_) { nM = M / BM; nN = N / BM; nwg = nM * nN; G = G_; c = c_; }
    __host__ __device__ bool next(int i, Unit& u) const {
        const long L = (long)i * G + c; if (L >= nwg) return false;
        int wgid = (int)L; { const int q = nwg / NXCD, r = nwg % NXCD, xcd = wgid % NXCD, off = wgid / NXCD; wgid = (xcd < r ? xcd * (q + 1) : r * (q + 1) + (xcd - r) * q) + off; }
        const int nig = WGM * nN, gid = wgid / nig, fm = gid * WGM, gsz = (nM - fm) < WGM ? (nM - fm) : WGM;
        u.pm = fm + ((wgid % nig) % gsz); u.pn = (wgid % nig) / gsz; return true;
    }
    __device__ __forceinline__ void a_ready(const Unit&) const {}
    __device__ __forceinline__ void done(const Unit&) const {}
};

#ifdef EMU
__device__ __forceinline__ unsigned cvt_pk_bf16(float lo, float hi) { return (unsigned)emu::f2bf(lo) | ((unsigned)emu::f2bf(hi) << 16); }
#else
__device__ __forceinline__ unsigned cvt_pk_bf16(float lo, float hi) { unsigned r; asm volatile("v_cvt_pk_bf16_f32 %0, %1, %2" : "=v"(r) : "v"(lo), "v"(hi)); return r; }
#endif
__device__ __forceinline__ u32x4 pack8(const f32x4 v0, const f32x4 v1) { u32x4 w; w.x = cvt_pk_bf16(v0[0], v0[1]); w.y = cvt_pk_bf16(v0[2], v0[3]); w.z = cvt_pk_bf16(v1[0], v1[1]); w.w = cvt_pk_bf16(v1[2], v1[3]); return w; }
__device__ __forceinline__ float fast_sigmoid(float x) { return __builtin_amdgcn_rcpf(1.0f + __expf(-x)); }
__device__ __forceinline__ f32x4 sigmoid4(const f32x4 v) { return (f32x4){fast_sigmoid(v[0]), fast_sigmoid(v[1]), fast_sigmoid(v[2]), fast_sigmoid(v[3])}; }
__device__ __forceinline__ f32x4 silu4(const f32x4 v) { return v * sigmoid4(v); }
struct EpiAtt {
    static constexpr bool PERM = true, AFTER_DRAIN = false;
    bf16_t* AQ; size_t tstride; const float* tabA;
    __device__ __forceinline__ void operator()(const f32x4 (&acc)[2][2][4][2], const Unit& u, int wr, int wc, int fr, int fq) const {
        const int t = u.pn / 6, ct = u.pn - 6 * t;
        bf16_t* base = AQ + (size_t)t * tstride;
        const float sc = (t == 0) ? 0.08838834764831845f : 1.0f;
        const int row0 = u.pm * BM + wr * 64 + fr, col0 = ct * BM + wc * 32 + 8 * fq;
        const bool rot = (t < 2) && (wc == 0);
        const float* cosT = tabA; const float* sinT = tabA + (size_t)CFG_SEQ * 16;
#pragma unroll
        for (int ai = 0; ai < 2; ++ai)
#pragma unroll
            for (int m = 0; m < 4; ++m) {
                const int row = row0 + ai * HALF + m * 16; bf16_t* rowp = base + (size_t)row * 1536 + col0;
                f32x4 c0 = {1.f, 1.f, 1.f, 1.f}, c1 = c0, s0 = {0.f, 0.f, 0.f, 0.f}, s1 = s0;
                if (rot) { const int pos = row % CFG_SEQ; const float* cp = cosT + (size_t)pos * 16 + 8 * (fq & 1); const float* sp = sinT + (size_t)pos * 16 + 8 * (fq & 1);
                    c0 = *(const f32x4*)cp; c1 = *(const f32x4*)(cp + 4); s0 = *(const f32x4*)sp; s1 = *(const f32x4*)(sp + 4); }
#pragma unroll
                for (int bj = 0; bj < 2; ++bj) {
                    f32x4 v0 = acc[ai][bj][m][0], v1 = acc[ai][bj][m][1];
                    if (rot) {
                        f32x4 o0, o1;
#pragma unroll
                        for (int e = 0; e < 4; ++e) { o0[e] = __shfl_xor(v0[e], 32); o1[e] = __shfl_xor(v1[e], 32); }
                        if (fq < 2) { v0 = v0 * c0 - o0 * s0; v1 = v1 * c1 - o1 * s1; }
                        else        { v0 = o0 * s0 + v0 * c0; v1 = o1 * s1 + v1 * c1; }
                    }
                    v0 = v0 * sc; v1 = v1 * sc;
                    *(u32x4*)(rowp + bj * HALF) = pack8(v0, v1);
                }
            }
    }
};
struct EpiRet {
    static constexpr bool PERM = true, AFTER_DRAIN = false;
    bf16_t* act; const float* tabR;
    static constexpr size_t oRQ = A_RQ / 2, oRK = A_RK / 2, oRV = A_RV / 2, oAR = A_AR / 2, oGR = A_GR / 2, oGA = A_GA / 2;
    __device__ __forceinline__ void operator()(const f32x4 (&acc)[2][2][4][2], const Unit& u, int wr, int wc, int fr, int fq) const {
        const int pn = u.pn; const int row0 = u.pm * BM + wr * 64 + fr, cw = wc * 32 + 8 * fq;
        if (pn < 8) {
            bf16_t* base = act + (pn < 4 ? oRQ : oRK); const float sc = pn < 4 ? 1.0f : 0.0625f; const int colh = (pn & 3) * 256 + cw;
            const float* cosT = tabR; const float* sinT = tabR + (size_t)CFG_SEQ * 128;
#pragma unroll
            for (int ai = 0; ai < 2; ++ai)
#pragma unroll
                for (int m = 0; m < 4; ++m) {
                    const int row = row0 + ai * HALF + m * 16, pos = row % CFG_SEQ; bf16_t* rowp = base + (size_t)row * 1024 + colh;
                    const float* cp = cosT + (size_t)pos * 128 + cw; const float* sp = sinT + (size_t)pos * 128 + cw;
                    const f32x4 c0 = *(const f32x4*)cp, c1 = *(const f32x4*)(cp + 4), s0 = *(const f32x4*)sp, s1 = *(const f32x4*)(sp + 4);
                    const f32x4 a0 = acc[ai][0][m][0], a1 = acc[ai][0][m][1], b0 = acc[ai][1][m][0], b1 = acc[ai][1][m][1];
                    *(u32x4*)(rowp) = pack8((a0 * c0 - b0 * s0) * sc, (a1 * c1 - b1 * s1) * sc);
                    *(u32x4*)(rowp + HALF) = pack8((a0 * s0 + b0 * c0) * sc, (a1 * s1 + b1 * c1) * sc);
                }
        } else {
            size_t boff; int ldc, col; int mode;
            if (pn < 16)      { boff = oRV; ldc = 2048; col = (pn - 8) * 256; mode = 0; }
            else if (pn < 24) { boff = oAR; ldc = 2560; col = 512 + (pn - 16) * 256; mode = 1; }
            else if (pn < 28) { boff = oGR; ldc = 1024; col = (pn - 24) * 256; mode = 2; }
            else              { boff = oGA; ldc = 1024; col = (pn - 28) * 256; mode = 2; }
            bf16_t* base = act + boff;
#pragma unroll
            for (int ai = 0; ai < 2; ++ai)
#pragma unroll
                for (int m = 0; m < 4; ++m) {
                    bf16_t* rowp = base + (size_t)(row0 + ai * HALF + m * 16) * ldc + col + cw;
#pragma unroll
                    for (int bj = 0; bj < 2; ++bj) {
                        f32x4 v0 = acc[ai][bj][m][0], v1 = acc[ai][bj][m][1];
                        if (mode == 1) { v0 = silu4(v0); v1 = silu4(v1); } else if (mode == 2) { v0 = sigmoid4(v0); v1 = sigmoid4(v1); }
                        *(u32x4*)(rowp + bj * HALF) = pack8(v0, v1);
                    }
                }
        }
    }
};
struct EpiGate {
    static constexpr bool PERM = true, AFTER_DRAIN = false;
    float* O32; bf16_t* O16; int ldc; const bf16_t* gate; int ldg; const float* add; int lda_;
    __device__ __forceinline__ void operator()(const f32x4 (&acc)[2][2][4][2], const Unit& u, int wr, int wc, int fr, int fq) const {
        const int row0 = u.pm * BM + wr * 64 + fr, col0 = u.pn * BM + wc * 32 + 8 * fq;
#pragma unroll
        for (int ai = 0; ai < 2; ++ai)
#pragma unroll
            for (int m = 0; m < 4; ++m) {
                const size_t row = (size_t)(row0 + ai * HALF + m * 16);
#pragma unroll
                for (int bj = 0; bj < 2; ++bj) {
                    f32x4 v0 = acc[ai][bj][m][0], v1 = acc[ai][bj][m][1]; const int col = col0 + bj * HALF;
                    if (gate) { const u32x4 g = *(const u32x4*)(gate + row * ldg + col);
                        v0 = v0 * (f32x4){__uint_as_float(g.x << 16), __uint_as_float(g.x & 0xffff0000u), __uint_as_float(g.y << 16), __uint_as_float(g.y & 0xffff0000u)};
                        v1 = v1 * (f32x4){__uint_as_float(g.z << 16), __uint_as_float(g.z & 0xffff0000u), __uint_as_float(g.w << 16), __uint_as_float(g.w & 0xffff0000u)}; }
                    if (add) { v0 = v0 + *(const f32x4*)(add + row * lda_ + col); v1 = v1 + *(const f32x4*)(add + row * lda_ + col + 4); }
                    if (O32) { *(f32x4*)(O32 + row * ldc + col) = v0; *(f32x4*)(O32 + row * ldc + col + 4) = v1; }
                    if (O16) *(u32x4*)(O16 + row * ldc + col) = pack8(v0, v1);
                }
            }
    }
};
struct EpiSwiGLU {
    static constexpr bool PERM = true, AFTER_DRAIN = false;
    bf16_t* O; int ldc;
    __device__ __forceinline__ void operator()(const f32x4 (&acc)[2][2][4][2], const Unit& u, int wr, int wc, int fr, int fq) const {
        const int row0 = u.pm * BM + wr * 64 + fr, col0 = u.pn * HALF + wc * 32 + 8 * fq;
#pragma unroll
        for (int ai = 0; ai < 2; ++ai)
#pragma unroll
            for (int m = 0; m < 4; ++m) {
                const size_t row = (size_t)(row0 + ai * HALF + m * 16);
                const f32x4 v0 = silu4(acc[ai][0][m][0]) * acc[ai][1][m][0], v1 = silu4(acc[ai][0][m][1]) * acc[ai][1][m][1];
                *(u32x4*)(O + row * ldc + col0) = pack8(v0, v1);
            }
    }
};

template <class Epi, class Sched, bool ALIGN_EPI = false, bool SP2 = false>
__device__ __forceinline__ void gemm_phase(PG8_LAS unsigned char* lds, const Gemm g, const Sched& S, const Epi& E) {
    int tid_ = threadIdx.x; OPAQUE_V(tid_); const int tid = tid_, wid = __builtin_amdgcn_readfirstlane(tid >> 6), lane = tid & 63, wr = wid >> 2, wc = wid & 3, fr = lane & 15, fq = lane >> 4;
    const int K = g.K, nt = K / BK;
    unsigned voffA[2], voffB[2];
#pragma unroll
    for (int i = 0; i < 2; ++i) { int R, C; stage_rc(tid * 16 + i * 8192, R, C); const int Rb = Epi::PERM ? ((R & ~31) + perm32(R & 31)) : R;
        voffA[i] = (unsigned)(R * g.lda + C) * 2u; voffB[i] = (unsigned)(Rb * g.ldb + C) * 2u; }
    const size_t kstep = (size_t)(BK * 2);
    const size_t hstepA = (size_t)HALF * g.lda * 2, hstepB = (size_t)HALF * g.ldb * 2;
    const size_t tstepA = 2 * hstepA, tstepB = 2 * hstepB;
    const unsigned ldsw = (unsigned)wid * 1024u;
    const int aoff = lds_byte(wr * 64 + fr, fq * 8), boff = lds_byte(wc * 32 + fr, fq * 8);
#define PG8_SA(b, h) (((b) * 2 + (h)) * HTB)
#define PG8_SB(b, h) ((4 + (b) * 2 + (h)) * HTB)
#define PG8_STAGE(bufoff, gbase, voff) do { _Pragma("unroll") for (int _i = 0; _i < 2; ++_i) \
        GLDS16((const char*)(gbase) + (voff)[_i], lds + (bufoff) + ldsw + _i * 8192); } while (0)
#define PG8_LDA(dst, b, h) do { _Pragma("unroll") for (int m = 0; m < 4; ++m) _Pragma("unroll") for (int k = 0; k < 2; ++k) dst[m][k] = *(const PG8_LAS bf16x8*)(lds + PG8_SA(b, h) + aoff + m * 2048 + k * 1024); } while (0)
#define PG8_LDB(dst, b, h) do { _Pragma("unroll") for (int n = 0; n < 2; ++n) _Pragma("unroll") for (int k = 0; k < 2; ++k) dst[n][k] = *(const PG8_LAS bf16x8*)(lds + PG8_SB(b, h) + boff + n * 2048 + k * 1024); } while (0)
#define PG8_MMA(ai, bj, At, Bt) do { __builtin_amdgcn_s_setprio(1); _Pragma("unroll") for (int m = 0; m < 4; ++m) _Pragma("unroll") for (int n = 0; n < 2; ++n) _Pragma("unroll") for (int k = 0; k < 2; ++k) \
        acc[ai][bj][m][n] = __builtin_amdgcn_mfma_f32_16x16x32_bf16(Bt[n][k], At[m][k], acc[ai][bj][m][n], 0, 0, 0); __builtin_amdgcn_s_setprio(0); } while (0)
#define PG8_WAIT_V(n) ASM_WAIT("s_waitcnt vmcnt(" #n ")")
#define PG8_WAIT_L(n) ASM_WAIT("s_waitcnt lgkmcnt(" #n ")")
#define PG8_BAR __builtin_amdgcn_s_barrier()
#define PG8_SCHED __builtin_amdgcn_sched_barrier(0)
    Unit cur, nxt; int ui = 0;
    if (!S.next(0, cur)) return;
    f32x4 acc[2][2][4][2];
#pragma unroll
    for (int a = 0; a < 2; ++a)
#pragma unroll
        for (int b = 0; b < 2; ++b)
#pragma unroll
            for (int m = 0; m < 4; ++m)
#pragma unroll
                for (int n = 0; n < 2; ++n) acc[a][b][m][n] = (f32x4){0.f, 0.f, 0.f, 0.f};
    bf16x8 At[4][2], B0[2][2], B1[2][2];
    const char* cA = (const char*)g.A + (size_t)cur.pm * tstepA; const char* cB = (const char*)g.Bt + (size_t)cur.pn * tstepB;
    S.a_ready(cur);
    if constexpr (SP2) {
        PG8_STAGE(PG8_SB(0, 0), cB, voffB); PG8_STAGE(PG8_SB(0, 1), cB + hstepB, voffB); PG8_STAGE(PG8_SA(0, 0), cA, voffA); PG8_STAGE(PG8_SA(0, 1), cA + hstepA, voffA);
        if (wr == 1) PG8_BAR;
        PG8_WAIT_V(2); PG8_BAR;
        PG8_STAGE(PG8_SB(1, 0), cB + kstep, voffB); PG8_STAGE(PG8_SA(1, 0), cA + kstep, voffA); PG8_STAGE(PG8_SB(1, 1), cB + hstepB + kstep, voffB);
        PG8_WAIT_V(6); PG8_BAR;
    } else {
        PG8_STAGE(PG8_SB(0, 0), cB, voffB); PG8_STAGE(PG8_SA(0, 0), cA, voffA); PG8_STAGE(PG8_SB(0, 1), cB + hstepB, voffB); PG8_STAGE(PG8_SA(0, 1), cA + hstepA, voffA);
        if (wr == 1) PG8_BAR;
        PG8_WAIT_V(4); PG8_BAR;
        PG8_STAGE(PG8_SB(1, 0), cB + kstep, voffB); PG8_STAGE(PG8_SA(1, 0), cA + kstep, voffA); PG8_STAGE(PG8_SB(1, 1), cB + hstepB + kstep, voffB);
        PG8_WAIT_V(6); PG8_BAR;
    }
    for (;;) {
        const bool has_next = S.next(ui + 1, nxt);
        const char* nA = has_next ? (const char*)g.A + (size_t)nxt.pm * tstepA : cA; const char* nB = has_next ? (const char*)g.Bt + (size_t)nxt.pn * tstepB : cB;
        for (int t = 0; t < nt; t += 2) {
            const bool last = (t == nt - 2);
            const char* a1 = cA + (size_t)(t + 1) * kstep;
            const char* a2 = last ? nA : cA + (size_t)(t + 2) * kstep; const char* b2 = last ? nB : cB + (size_t)(t + 2) * kstep;
            const char* a3 = a2 + kstep; const char* b3 = b2 + kstep;
            if (last && has_next) S.a_ready(nxt);
            if constexpr (SP2) {
            PG8_LDB(B0, 0, 0); PG8_LDB(B1, 0, 1); PG8_SCHED; PG8_LDA(At, 0, 0); PG8_STAGE(PG8_SA(1, 1), a1 + hstepA, voffA);
            PG8_WAIT_V(8); PG8_WAIT_L(0); PG8_BAR; PG8_MMA(0, 0, At, B0); PG8_MMA(0, 1, At, B1); PG8_BAR; PG8_SCHED;
            PG8_LDA(At, 0, 1); PG8_STAGE(PG8_SB(0, 0), b2, voffB); PG8_STAGE(PG8_SB(0, 1), b2 + hstepB, voffB); PG8_STAGE(PG8_SA(0, 0), a2, voffA);
            PG8_WAIT_V(8); PG8_WAIT_L(0); PG8_BAR; PG8_MMA(1, 0, At, B0); PG8_MMA(1, 1, At, B1); PG8_BAR; PG8_SCHED;
            PG8_LDB(B0, 1, 0); PG8_LDB(B1, 1, 1); PG8_SCHED; PG8_LDA(At, 1, 0); PG8_STAGE(PG8_SA(0, 1), a2 + hstepA, voffA);
            PG8_WAIT_V(8); PG8_WAIT_L(0); PG8_BAR; PG8_MMA(0, 0, At, B0); PG8_MMA(0, 1, At, B1); PG8_BAR; PG8_SCHED;
            PG8_LDA(At, 1, 1); PG8_STAGE(PG8_SB(1, 0), b3, voffB); PG8_STAGE(PG8_SB(1, 1), b3 + hstepB, voffB); PG8_STAGE(PG8_SA(1, 0), a3, voffA);
            PG8_WAIT_V(8); PG8_WAIT_L(0); PG8_BAR; PG8_MMA(1, 0, At, B0); PG8_MMA(1, 1, At, B1); PG8_BAR; PG8_SCHED;
            } else {
            PG8_LDB(B0, 0, 0); PG8_SCHED; PG8_LDA(At, 0, 0); PG8_STAGE(PG8_SA(1, 1), a1 + hstepA, voffA);
            PG8_WAIT_L(8); PG8_BAR; PG8_WAIT_L(0); PG8_MMA(0, 0, At, B0); PG8_BAR; PG8_SCHED;
            PG8_LDB(B1, 0, 1); PG8_STAGE(PG8_SB(0, 0), b2, voffB);
            PG8_BAR; PG8_WAIT_L(0); PG8_MMA(0, 1, At, B1); PG8_BAR;
            PG8_LDA(At, 0, 1); PG8_STAGE(PG8_SA(0, 0), a2, voffA);
            PG8_BAR; PG8_WAIT_L(0); PG8_MMA(1, 0, At, B0); PG8_BAR; PG8_SCHED;
            PG8_STAGE(PG8_SB(0, 1), b2 + hstepB, voffB);
            PG8_WAIT_V(6); PG8_BAR; PG8_MMA(1, 1, At, B1); PG8_BAR;
            PG8_LDB(B0, 1, 0); PG8_SCHED; PG8_LDA(At, 1, 0); PG8_STAGE(PG8_SA(0, 1), a2 + hstepA, voffA);
            PG8_WAIT_L(8); PG8_BAR; PG8_WAIT_L(0); PG8_MMA(0, 0, At, B0); PG8_BAR; PG8_SCHED;
            PG8_LDB(B1, 1, 1); PG8_STAGE(PG8_SB(1, 0), b3, voffB);
            PG8_BAR; PG8_WAIT_L(0); PG8_MMA(0, 1, At, B1); PG8_BAR;
            PG8_LDA(At, 1, 1); PG8_STAGE(PG8_SA(1, 0), a3, voffA);
            PG8_BAR; PG8_WAIT_L(0); PG8_MMA(1, 0, At, B0); PG8_BAR; PG8_SCHED;
            PG8_STAGE(PG8_SB(1, 1), b3 + hstepB, voffB);
            PG8_WAIT_V(6); PG8_BAR; PG8_MMA(1, 1, At, B1); PG8_BAR;
            }
        }
        if constexpr (ALIGN_EPI) { if (wr == 0) PG8_BAR; }
        if constexpr (!Epi::AFTER_DRAIN) { E(acc, cur, wr, wc, fr, fq); S.done(cur); }
        if (!has_next) break;
#pragma unroll
        for (int a = 0; a < 2; ++a)
#pragma unroll
            for (int b = 0; b < 2; ++b)
#pragma unroll
                for (int m = 0; m < 4; ++m)
#pragma unroll
                    for (int n = 0; n < 2; ++n) acc[a][b][m][n] = (f32x4){0.f, 0.f, 0.f, 0.f};
        cur = nxt; cA = nA; cB = nB; ++ui;
        if constexpr (ALIGN_EPI) { if (wr == 1) PG8_BAR; }
    }
    PG8_WAIT_V(0);
    if constexpr (!ALIGN_EPI) { if (wr == 0) PG8_BAR; }
    PG8_BAR;
    if constexpr (Epi::AFTER_DRAIN) { E.fused(acc, cur, wr, wc, fr, fq, lds, wid, lane); S.done(cur); }
#undef PG8_SA
#undef PG8_SB
#undef PG8_STAGE
#undef PG8_LDA
#undef PG8_LDB
#undef PG8_MMA
#undef PG8_WAIT_V
#undef PG8_WAIT_L
#undef PG8_BAR
#undef PG8_SCHED
}
}
constexpr int RING_OFF = 0, RING_BYTES = 143360;
constexpr int LDSCTL_OFF = RING_BYTES, MISC_OFF = LDSCTL_OFF + 320;
constexpr int LDS_BYTES = 147456;
static_assert(MISC_OFF + 128 <= LDS_BYTES && pg8::STAGE_BYTES <= RING_BYTES, "LDS map");

typedef unsigned short bf16;
typedef unsigned v4u __attribute__((ext_vector_type(4)));
typedef unsigned v2u __attribute__((ext_vector_type(2)));
typedef float f32x4 __attribute__((ext_vector_type(4)));
typedef GAS unsigned gu32;
#define RLX_AGENT __ATOMIC_RELAXED, __HIP_MEMORY_SCOPE_AGENT
#define LDS_WAIT() ASM_WAIT("s_waitcnt lgkmcnt(0)")
#define VM_WAIT() ASM_WAIT("s_waitcnt vmcnt(0)")
#ifdef EMU
#define WAVE_SYNC() do { int _z = 0; (void)__shfl_xor(_z, 0); } while (0)
#else
#define WAVE_SYNC() do { asm volatile("s_waitcnt lgkmcnt(0)" ::: "memory"); __builtin_amdgcn_wave_barrier(); } while (0)
#endif
__device__ __forceinline__ unsigned f2bf(float f) { unsigned u = __float_as_uint(f); return (u + 0x7fffu + ((u >> 16) & 1u)) >> 16; }
__device__ __forceinline__ unsigned pk2(float lo, float hi) { return f2bf(lo) | (f2bf(hi) << 16); }
__device__ __forceinline__ float bflo(unsigned w) { return __uint_as_float(w << 16); }
__device__ __forceinline__ float bfhi(unsigned w) { return __uint_as_float(w & 0xffff0000u); }
__device__ __forceinline__ float bf2f(bf16 h) { return __uint_as_float((unsigned)h << 16); }

#define XB_TMO      128
#define XB_XCNT(j)  (256  + 64 * (j))
#define XB_XSUB(j)  (1280 + 64 * (j))
#define XB_XGEN(j)  (2304 + 64 * (j))
#define XB_TOP      3328
#define XB_TOPGEN   3392
#define XCD_BAR_WORDS 3456
#define XB_SPIN_CAP (1u << 18)

__device__ __forceinline__ unsigned xb_ld(unsigned* p)              { return __hip_atomic_load(p, __ATOMIC_RELAXED, __HIP_MEMORY_SCOPE_AGENT); }
__device__ __forceinline__ unsigned xb_add(unsigned* p, unsigned v) { return __hip_atomic_fetch_add(p, v, __ATOMIC_RELAXED, __HIP_MEMORY_SCOPE_AGENT); }
__device__ __forceinline__ unsigned xb_xcc_id() { return (unsigned)__builtin_amdgcn_s_getreg((3 << 11) | 20) & 0xFu; }
#define XB_SPIN(cond, bar) do { unsigned _sp = 0; while (cond) { __builtin_amdgcn_s_sleep(1); \
    if ((++_sp & 255u) == 0u) { if (xb_ld(&(bar)[XB_TMO])) break; if (_sp > XB_SPIN_CAP) { atomicAdd(&(bar)[XB_TMO], 1u); break; } } } } while (0)

struct XcdBarrier {
    unsigned* bar; unsigned x;
    volatile LAS unsigned* st;
};

__device__ __forceinline__ XcdBarrier xcd_barrier_post(unsigned* bar, volatile LAS unsigned* st) {
    XcdBarrier b; b.bar = bar; b.x = xb_xcc_id(); b.st = st;
    if (threadIdx.x == 0) (void)xb_add(&bar[XB_XCNT(b.x)], 1u);
    return b;
}
__device__ __forceinline__ void xcd_barrier_complete(unsigned* bar, unsigned x, unsigned& nloc, unsigned& nx) {
    const unsigned G = gridDim.x * gridDim.y * gridDim.z;
    unsigned sum, cnt, mine, sp = 0u;
    for (;;) {
        sum = 0u; cnt = 0u; mine = 0u;
#pragma unroll
        for (unsigned j = 0; j < 16; ++j) { const unsigned c = xb_ld(&bar[XB_XCNT(j)]); sum += c; cnt += (c > 0u) ? 1u : 0u; mine = (j == x) ? c : mine; }
        if (sum == G) break;
        __builtin_amdgcn_s_sleep(1);
        if ((++sp & 255u) == 0u) { if (xb_ld(&bar[XB_TMO])) break; if (sp > XB_SPIN_CAP) { atomicAdd(&bar[XB_TMO], 1u); break; } }
    }
    nloc = mine > 0u ? mine : 1u; nx = cnt > 0u ? cnt : 1u;
}

__device__ __forceinline__ void xcd_barrier(const XcdBarrier& b) {
    VM_WAIT();
    __syncthreads();
    if (threadIdx.x == 0) {
        unsigned* bar = b.bar;
        __builtin_amdgcn_s_waitcnt(0);
        unsigned nloc = b.st[0], nx = b.st[1];
        if (nloc == 0u) { xcd_barrier_complete(bar, b.x, nloc, nx); b.st[0] = nloc; b.st[1] = nx; }
        const unsigned old = xb_add(&bar[XB_XSUB(b.x)], 1u);
        const unsigned gen = old / nloc;
        if (old + 1u == (gen + 1u) * nloc) {
            __builtin_amdgcn_fence(__ATOMIC_RELEASE, "agent");
            VM_WAIT();
            const unsigned og = xb_add(&bar[XB_TOP], 1u);
            const unsigned tg = og / nx;
            if (og + 1u == (tg + 1u) * nx) xb_add(&bar[XB_TOPGEN], 1u);
            else XB_SPIN(xb_ld(&bar[XB_TOPGEN]) == tg, bar);
            __builtin_amdgcn_fence(__ATOMIC_ACQUIRE, "agent");
            xb_add(&bar[XB_XGEN(b.x)], 1u);
            VM_WAIT();
        } else {
            XB_SPIN(xb_ld(&bar[XB_XGEN(b.x)]) == gen, bar);
            __builtin_amdgcn_fence(__ATOMIC_ACQUIRE, "agent");
            VM_WAIT();
        }
    }
    __syncthreads();
}

struct Frame {
    LAS unsigned char* lds;
    volatile LAS unsigned* MISC;
    gu32* ctl;
    unsigned char* ws;
    int tid, lane, wave;
    int vcu, G;
};
__device__ __forceinline__ float wave_sum(float v) {
#pragma unroll
    for (int o = 1; o < 64; o <<= 1) v += __shfl_xor(v, o);
    return v;
}
__device__ __forceinline__ float wave_max(float v) {
#pragma unroll
    for (int o = 1; o < 64; o <<= 1) v = fmaxf(v, __shfl_xor(v, o));
    return v;
}
__device__ __forceinline__ void p0_transpose_item(const float* W, int N, bf16* WT, int ldt, int drow0, int kdst0, int k0, int n0, LAS float* scr, int lane) {
#pragma unroll 8
    for (int i = 0; i < 32; ++i) { const int kk = 2 * i + (lane >> 5); scr[kk * 33 + (lane & 31)] = W[(size_t)(k0 + kk) * N + n0 + (lane & 31)]; }
    WAVE_SYNC();
    const int c = lane & 7;
#pragma unroll
    for (int j = 0; j < 4; ++j) { const int n = (lane >> 3) + 8 * j; const LAS float* s = scr + (8 * c) * 33 + n;
        v4u o; o.x = pk2(s[0 * 33], s[1 * 33]); o.y = pk2(s[2 * 33], s[3 * 33]); o.z = pk2(s[4 * 33], s[5 * 33]); o.w = pk2(s[6 * 33], s[7 * 33]);
        *(v4u*)(WT + (size_t)(drow0 + n) * ldt + kdst0 + k0 + 8 * c) = o; }
    WAVE_SYNC();
}
__device__ __forceinline__ void p0_weights(Frame& F, const float* const* in, int l) {
    LAS float* scr = (LAS float*)(F.lds + RING_OFF + F.wave * 16384);
    const int gw = F.vcu * NWAVES + F.wave, NGW = F.G * NWAVES;
    bf16* WinT = (bf16*)(F.ws + WS_WIN); bf16* WmT = (bf16*)(F.ws + WS_WM); bf16* WoT = (bf16*)(F.ws + WS_WO); bf16* WguT = (bf16*)(F.ws + WS_WGU); bf16* WdT = (bf16*)(F.ws + WS_WD);
    const float* w_in = in[1] + (size_t)l * D * DIN; const float* w_ro = in[2] + (size_t)l * 2048 * D; const float* w_ao = in[3] + (size_t)l * 512 * D;
    const float* w_o = in[4] + (size_t)l * D * D; const float* w_g = in[5] + (size_t)l * D * DFF; const float* w_u = in[6] + (size_t)l * D * DFF; const float* w_d = in[7] + (size_t)l * DFF * D;
    constexpr int I_IN = (D / 64) * (DIN / 32), I_AO = (512 / 64) * (D / 32), I_RO = (2048 / 64) * (D / 32), I_O = (D / 64) * (D / 32), I_G = (D / 64) * (DFF / 32), I_D = (DFF / 64) * (D / 32);
    constexpr int NITEMS = I_IN + I_AO + I_RO + I_O + 2 * I_G + I_D;
    for (int it = gw; it < NITEMS; it += NGW) {
        int r = it;
        if (r < I_IN) { const int nb = r % (DIN / 32), kb = r / (DIN / 32), n0 = nb * 32;
            const int drow0 = (n0 >= 6144 && n0 < 10752) ? n0 - 6144 : (n0 < 6144 ? n0 + 4608 : n0);
            p0_transpose_item(w_in, DIN, WinT, D, drow0, 0, kb * 64, n0, scr, F.lane); continue; } r -= I_IN;
        if (r < I_AO) { const int nb = r % (D / 32), kb = r / (D / 32); p0_transpose_item(w_ao, D, WmT, 2560, nb * 32, 0, kb * 64, nb * 32, scr, F.lane); continue; } r -= I_AO;
        if (r < I_RO) { const int nb = r % (D / 32), kb = r / (D / 32); p0_transpose_item(w_ro, D, WmT, 2560, nb * 32, 512, kb * 64, nb * 32, scr, F.lane); continue; } r -= I_RO;
        if (r < I_O) { const int nb = r % (D / 32), kb = r / (D / 32); p0_transpose_item(w_o, D, WoT, D, nb * 32, 0, kb * 64, nb * 32, scr, F.lane); continue; } r -= I_O;
        if (r < 2 * I_G) { const int up = r >= I_G; if (up) r -= I_G; const int nb = r % (DFF / 32), kb = r / (DFF / 32), n0 = nb * 32;
            const int drow0 = (n0 >> 7) * 256 + (up ? 128 : 0) + (n0 & 127);
            p0_transpose_item(up ? w_u : w_g, DFF, WguT, D, drow0, 0, kb * 64, n0, scr, F.lane); continue; } r -= 2 * I_G;
        { const int nb = r % (D / 32), kb = r / (D / 32); p0_transpose_item(w_d, D, WdT, DFF, nb * 32, 0, kb * 64, nb * 32, scr, F.lane); }
    }
}
__device__ __forceinline__ void sincos_rr(float a, float& cs, float& sn) {
    const float k = rintf(a * 0.15915494309189535f);
    float r = fmaf(-k, 6.28125f, a); r = fmaf(-k, 1.9353071795864769e-3f, r); r = fmaf(-k, 2.5e-20f, r);
#ifdef EMU
    cs = cosf(r); sn = sinf(r);
#else
    cs = __cosf(r); sn = __sinf(r);
#endif
}
__device__ __forceinline__ void p0_tables(Frame& F) {
    float* tabR = (float*)(F.ws + WS_TABR); float* tabA = (float*)(F.ws + WS_TABA);
    const int gt = F.vcu * (NWAVES * 64) + F.tid, NT = F.G * NWAVES * 64;
    for (int i = gt; i < SEQ * 128; i += NT) { const int pos = i >> 7, d = i & 127; const float inv = powf(10000.0f, -(float)d / 128.0f); const float ang = (float)pos * inv;
        float cs, sn; sincos_rr(ang, cs, sn); tabR[i] = cs; tabR[(size_t)SEQ * 128 + i] = sn; }
    for (int i = gt; i < SEQ * 16; i += NT) { const int pos = i >> 4, d = i & 15; const float inv = powf(500000.0f, -(float)d / 16.0f); const float ang = (float)pos * inv;
        float cs, sn; sincos_rr(ang, cs, sn); tabA[i] = cs; tabA[(size_t)SEQ * 16 + i] = sn; }
}
__device__ __forceinline__ void rms_row_to_bf16(const float* xrow, const float* g, bf16* orow, int lane) {
    const f32x4* xr = (const f32x4*)xrow + lane; const f32x4* gr = (const f32x4*)g + lane;
    f32x4 v[4]; float s = 0.f;
#pragma unroll
    for (int j = 0; j < 4; ++j) { v[j] = xr[64 * j]; s += (v[j].x * v[j].x + v[j].y * v[j].y) + (v[j].z * v[j].z + v[j].w * v[j].w); }
    const float rstd = 1.0f / sqrtf(wave_sum(s) * (1.0f / D) + NORM_EPS);
    unsigned long long* o8 = (unsigned long long*)orow + lane;
#pragma unroll
    for (int j = 0; j < 4; ++j) { const f32x4 gg = gr[64 * j]; o8[64 * j] = (unsigned long long)pk2(v[j].x * rstd * gg.x, v[j].y * rstd * gg.y) | ((unsigned long long)pk2(v[j].z * rstd * gg.z, v[j].w * rstd * gg.w) << 32); }
}
__device__ __forceinline__ void p_norm_rows(Frame& F, const float* X, const float* g, bf16* XN) {
    const int gw = F.vcu * NWAVES + F.wave, NGW = F.G * NWAVES;
    for (int m = gw; m < M; m += NGW) rms_row_to_bf16(X + (size_t)m * D, g, XN + (size_t)m * D, F.lane);
}
__device__ __forceinline__ void p_resid_rows(Frame& F, const float* Y, const float* Xi, float* Xo, const float* g1, const float* g2, bf16* XN) {
    const int gw = F.vcu * NWAVES + F.wave, NGW = F.G * NWAVES, lane = F.lane;
    for (int m = gw; m < M; m += NGW) {
        const f32x4* yr = (const f32x4*)(Y + (size_t)m * D) + lane; const f32x4* xr = (const f32x4*)(Xi + (size_t)m * D) + lane; f32x4* xo = (f32x4*)(Xo + (size_t)m * D) + lane;
        f32x4 v[4], x[4]; float s = 0.f;
#pragma unroll
        for (int j = 0; j < 4; ++j) { v[j] = yr[64 * j]; x[j] = xr[64 * j]; s += (v[j].x * v[j].x + v[j].y * v[j].y) + (v[j].z * v[j].z + v[j].w * v[j].w); }
        const float rstd = 1.0f / sqrtf(wave_sum(s) * (1.0f / D) + NORM_EPS); float s2 = 0.f;
#pragma unroll
        for (int j = 0; j < 4; ++j) { const f32x4 gg = ((const f32x4*)g1 + lane)[64 * j]; x[j] = x[j] + v[j] * rstd * gg; xo[64 * j] = x[j]; s2 += (x[j].x * x[j].x + x[j].y * x[j].y) + (x[j].z * x[j].z + x[j].w * x[j].w); }
        if (g2) { const float r2 = 1.0f / sqrtf(wave_sum(s2) * (1.0f / D) + NORM_EPS); unsigned long long* o8 = (unsigned long long*)(XN + (size_t)m * D) + lane;
#pragma unroll
            for (int j = 0; j < 4; ++j) { const f32x4 gg = ((const f32x4*)g2 + lane)[64 * j]; o8[64 * j] = (unsigned long long)pk2(x[j].x * r2 * gg.x, x[j].y * r2 * gg.y) | ((unsigned long long)pk2(x[j].z * r2 * gg.z, x[j].w * r2 * gg.w) << 32); } }
    }
}

__device__ __forceinline__ void att_unit_scalar(Frame& F, int u) {
    bf16* AQ = (bf16*)(F.ws + WS_ACT + A_AQ); const bf16* AK = (const bf16*)(F.ws + WS_ACT + A_AK); const bf16* AV = (const bf16*)(F.ws + WS_ACT + A_AV); float* LSE = (float*)(F.ws + WS_LSE);
    const int b = u / (12 * NBLK), rem = u % (12 * NBLK), gi = rem / (4 * NBLK), rem2 = rem % (4 * NBLK), j = rem2 / NBLK, blk = rem2 % NBLK;
    const int r = gi == 0 ? 1 : (gi == 1 ? 4 : 16), nb = NBLK / r, p = blk / nb, n = blk % nb, head = gi * 4 + j;
    LAS bf16* Kl = (LAS bf16*)(F.lds);
    LAS bf16* Vl = (LAS bf16*)(F.lds + 66560);
    LAS float* qs = (LAS float*)(F.lds + 66560 + 65536) + F.wave * 128;
    LAS float* ps = (LAS float*)(F.lds + 66560 + 65536 + 4096) + F.wave * 132;
    for (int idx = F.tid; idx < 256 * 16; idx += NWAVES * 64) {
        const int m = idx >> 4, ch = idx & 15; const int ti = 128 * (n - 1) + m;
        v4u kv = {0u, 0u, 0u, 0u}, vv = {0u, 0u, 0u, 0u};
        if (ti >= 0) { const size_t off = ((size_t)b * SEQ + p + (size_t)r * ti) * 1536 + head * 128 + ch * 8; kv = *(const v4u*)(AK + off); vv = *(const v4u*)(AV + off); }
        LAS unsigned* kd = (LAS unsigned*)(Kl + m * 130 + ch * 8); kd[0] = kv.x; kd[1] = kv.y; kd[2] = kv.z; kd[3] = kv.w;
        *(LAS v4u*)(Vl + m * 128 + ch * 8) = vv;
    }
    __syncthreads();
    const int lane = F.lane;
    for (int i = 0; i < 16; ++i) {
        const int c = F.wave * 16 + i; const size_t tok = (size_t)b * SEQ + p + (size_t)r * (128 * n + c);
        bf16* qrow = AQ + tok * 1536 + head * 128;
        { const unsigned w = *(const unsigned*)(qrow + 2 * lane); qs[2 * lane] = bflo(w); qs[2 * lane + 1] = bfhi(w); }
        WAVE_SYNC();
        float sc[3]; float mx = -3.0e38f;
#pragma unroll
        for (int kk = 0; kk < 3; ++kk) {
            const int mrel = lane + 64 * kk, m = c + mrel; const bool valid = (mrel <= 128) && (n > 0 || m >= 128);
            float s = 0.f;
            if (valid) { const LAS unsigned* kr = (const LAS unsigned*)(Kl + m * 130);
                for (int d2 = 0; d2 < 64; ++d2) { const unsigned w = kr[d2]; s += qs[2 * d2] * bflo(w) + qs[2 * d2 + 1] * bfhi(w); } }
            sc[kk] = valid ? s : -3.0e38f; mx = fmaxf(mx, sc[kk]);
        }
        mx = wave_max(mx);
        float sum = 0.f;
#pragma unroll
        for (int kk = 0; kk < 3; ++kk) { const float e = sc[kk] > -1.0e38f ? __expf(sc[kk] - mx) : 0.f; sum += e; if (lane + 64 * kk < 132) ps[lane + 64 * kk] = e; }
        sum = wave_sum(sum);
        WAVE_SYNC();
        float o0 = 0.f, o1 = 0.f;
        for (int mrel = 0; mrel <= 128; ++mrel) { const float pw = ps[mrel]; const unsigned w = *(const LAS unsigned*)(Vl + (c + mrel) * 128 + 2 * lane); o0 += pw * bflo(w); o1 += pw * bfhi(w); }
        const float inv = 1.0f / sum;
        *(unsigned*)(qrow + 2 * lane) = pk2(o0 * inv, o1 * inv);
        if (lane == 0) LSE[((size_t)gi * M + tok) * 4 + j] = mx + __logf(sum);
        WAVE_SYNC();
    }
    __syncthreads();
}
__device__ __forceinline__ void p_att_merge(Frame& F) {
    const bf16* AQ = (const bf16*)(F.ws + WS_ACT + A_AQ); bf16* AR = (bf16*)(F.ws + WS_ACT + A_AR); const float* LSE = (const float*)(F.ws + WS_LSE);
    const int gw = F.vcu * NWAVES + F.wave, NGW = F.G * NWAVES, lane = F.lane, j = lane >> 4, d0 = (lane & 15) * 8;
    for (int t = gw; t < M; t += NGW) {
        float l[3]; float mx = -3.0e38f;
#pragma unroll
        for (int g = 0; g < 3; ++g) { l[g] = LSE[((size_t)g * M + t) * 4 + j]; mx = fmaxf(mx, l[g]); }
        float w[3]; float ws_ = 0.f;
#pragma unroll
        for (int g = 0; g < 3; ++g) { w[g] = __expf(l[g] - mx); ws_ += w[g]; }
        const float inv = 1.0f / ws_;
        float o[8] = {0.f, 0.f, 0.f, 0.f, 0.f, 0.f, 0.f, 0.f};
#pragma unroll
        for (int g = 0; g < 3; ++g) { const v4u q = *(const v4u*)(AQ + (size_t)t * 1536 + (g * 4 + j) * 128 + d0); const float wg = w[g] * inv;
            o[0] += wg * bflo(q.x); o[1] += wg * bfhi(q.x); o[2] += wg * bflo(q.y); o[3] += wg * bfhi(q.y); o[4] += wg * bflo(q.z); o[5] += wg * bfhi(q.z); o[6] += wg * bflo(q.w); o[7] += wg * bfhi(q.w); }
        v4u ov; ov.x = pk2(o[0], o[1]); ov.y = pk2(o[2], o[3]); ov.z = pk2(o[4], o[5]); ov.w = pk2(o[6], o[7]);
        *(v4u*)(AR + (size_t)t * 2560 + j * 128 + d0) = ov;
    }
}

struct RetConst { float lg, a, a8; };
__device__ __forceinline__ RetConst ret_const(int h) { RetConst c; c.lg = logf(1.0f - exp2f(-5.0f - (float)h)); c.a = expf(128.0f * c.lg); c.a8 = expf(1024.0f * c.lg); return c; }
__device__ __forceinline__ void ret_pass1_scalar(Frame& F, int ur) {
    const bf16* RK = (const bf16*)(F.ws + WS_ACT + A_RK); const bf16* RV = (const bf16*)(F.ws + WS_ACT + A_RV); float* FS = (float*)(F.ws + WS_ACT + A_F);
    const int g = ur % NSEG, s = (ur / NSEG) & 3, h = (ur / (NSEG * 4)) & 3, b = ur / (NSEG * 16);
    const RetConst rc = ret_const(h);
    const int dv = F.tid & 127, dkg = F.tid >> 7;
    float R[64];
#pragma unroll
    for (int jj = 0; jj < 64; ++jj) R[jj] = 0.f;
    for (int i = 0; i < 8; ++i) {
        const size_t tb = (size_t)b * SEQ + (size_t)(g * 8 + i) * 128;
#pragma unroll
        for (int jj = 0; jj < 64; ++jj) R[jj] *= rc.a;
        for (int c = 0; c < 128; ++c) {
            const float v = bf2f(RV[(tb + c) * 2048 + h * 512 + s * 128 + dv]) * expf((float)(127 - c) * rc.lg);
            const v4u* kp = (const v4u*)(RK + (tb + c) * 1024 + h * 256 + dkg * 64);
#pragma unroll
            for (int q = 0; q < 8; ++q) { const v4u k = kp[q];
                R[8 * q + 0] += bflo(k.x) * v; R[8 * q + 1] += bfhi(k.x) * v; R[8 * q + 2] += bflo(k.y) * v; R[8 * q + 3] += bfhi(k.y) * v;
                R[8 * q + 4] += bflo(k.z) * v; R[8 * q + 5] += bfhi(k.z) * v; R[8 * q + 6] += bflo(k.w) * v; R[8 * q + 7] += bfhi(k.w) * v; }
        }
    }
    float* fo = FS + (size_t)ur * 32768;
#pragma unroll
    for (int jj = 0; jj < 64; ++jj) fo[(dkg * 64 + jj) * 128 + dv] = R[jj];
}
__device__ __forceinline__ void ret_pass2_scalar(Frame& F, int ur) {
    const bf16* RQ = (const bf16*)(F.ws + WS_ACT + A_RQ); const bf16* RK = (const bf16*)(F.ws + WS_ACT + A_RK); bf16* RV = (bf16*)(F.ws + WS_ACT + A_RV); const float* FS = (const float*)(F.ws + WS_ACT + A_F);
    const int g = ur % NSEG, s = (ur / NSEG) & 3, h = (ur / (NSEG * 4)) & 3, b = ur / (NSEG * 16);
    const RetConst rc = ret_const(h);
    const int tid = F.tid, dv = tid & 127, dkg = tid >> 7;
    LAS bf16* Rl = (LAS bf16*)(F.lds);
    LAS bf16* Sl = (LAS bf16*)(F.lds + 65536);
    LAS bf16* Vl = (LAS bf16*)(F.lds + 65536 + 32768);
    float R[64];
#pragma unroll
    for (int jj = 0; jj < 64; ++jj) R[jj] = 0.f;
    for (int gp = 0; gp < g; ++gp) { const float wgt = expf((float)(1024 * (g - 1 - gp)) * rc.lg); const float* fi = FS + (size_t)(ur - g + gp) * 32768;
#pragma unroll
        for (int jj = 0; jj < 64; ++jj) R[jj] += wgt * fi[(dkg * 64 + jj) * 128 + dv]; }
    for (int i = 0; i < 8; ++i) {
        const size_t tb = (size_t)b * SEQ + (size_t)(g * 8 + i) * 128;
#pragma unroll
        for (int jj = 0; jj < 64; ++jj) Rl[(dkg * 64 + jj) * 128 + dv] = (bf16)f2bf(R[jj]);
        for (int e = tid; e < 128 * 128; e += NWAVES * 64) { const int c = e >> 7;  Vl[e] = RV[(tb + c) * 2048 + h * 512 + s * 128 + (e & 127)]; }
        for (int e = tid; e < 128 * 128; e += NWAVES * 64) { const int c = e >> 7, cp = e & 127; float sv = 0.f;
            if (cp <= c) { const v4u* qp = (const v4u*)(RQ + (tb + c) * 1024 + h * 256); const v4u* kp = (const v4u*)(RK + (tb + cp) * 1024 + h * 256);
                for (int q = 0; q < 32; ++q) { const v4u a = qp[q], k = kp[q];
                    sv += bflo(a.x) * bflo(k.x) + bfhi(a.x) * bfhi(k.x) + bflo(a.y) * bflo(k.y) + bfhi(a.y) * bfhi(k.y) + bflo(a.z) * bflo(k.z) + bfhi(a.z) * bfhi(k.z) + bflo(a.w) * bflo(k.w) + bfhi(a.w) * bfhi(k.w); }
                sv *= expf((float)(c - cp) * rc.lg); }
            Sl[e] = (bf16)f2bf(sv); }
        __syncthreads();
        for (int ci = 0; ci < 32; ++ci) { const int c = dkg * 32 + ci; float cross = 0.f, intra = 0.f;
            const v4u* qp = (const v4u*)(RQ + (tb + c) * 1024 + h * 256);
            for (int q = 0; q < 32; ++q) { const v4u a = qp[q]; const LAS bf16* rp = Rl + (8 * q) * 128 + dv;
                cross += bflo(a.x) * bf2f(rp[0]) + bfhi(a.x) * bf2f(rp[128]) + bflo(a.y) * bf2f(rp[256]) + bfhi(a.y) * bf2f(rp[384]) + bflo(a.z) * bf2f(rp[512]) + bfhi(a.z) * bf2f(rp[640]) + bflo(a.w) * bf2f(rp[768]) + bfhi(a.w) * bf2f(rp[896]); }
            for (int cp = 0; cp <= c; ++cp) intra += bf2f(Sl[c * 128 + cp]) * bf2f(Vl[cp * 128 + dv]);
            const float y = expf((float)(c + 1) * rc.lg) * cross + intra;
            RV[(tb + c) * 2048 + h * 512 + s * 128 + dv] = (bf16)f2bf(y); }
#pragma unroll
        for (int jj = 0; jj < 64; ++jj) R[jj] *= rc.a;
        for (int c = 0; c < 128; ++c) {
            const float v = bf2f(Vl[c * 128 + dv]) * expf((float)(127 - c) * rc.lg);
            const v4u* kp = (const v4u*)(RK + (tb + c) * 1024 + h * 256 + dkg * 64);
#pragma unroll
            for (int q = 0; q < 8; ++q) { const v4u k = kp[q];
                R[8 * q + 0] += bflo(k.x) * v; R[8 * q + 1] += bfhi(k.x) * v; R[8 * q + 2] += bflo(k.y) * v; R[8 * q + 3] += bfhi(k.y) * v;
                R[8 * q + 4] += bflo(k.z) * v; R[8 * q + 5] += bfhi(k.z) * v; R[8 * q + 6] += bflo(k.w) * v; R[8 * q + 7] += bfhi(k.w) * v; }
        }
        __syncthreads();
    }
}
__device__ __forceinline__ void p_ret_finalize(Frame& F) {
    const bf16* Y = (const bf16*)(F.ws + WS_ACT + A_RV); bf16* AR = (bf16*)(F.ws + WS_ACT + A_AR);
    const int gw = F.vcu * NWAVES + F.wave, NGW = F.G * NWAVES, lane = F.lane;
    for (int rr = gw; rr < M * 4; rr += NGW) { const int t = rr >> 2, h = rr & 3;
        const v4u q = *(const v4u*)(Y + (size_t)t * 2048 + h * 512 + lane * 8);
        float y[8] = {bflo(q.x), bfhi(q.x), bflo(q.y), bfhi(q.y), bflo(q.z), bfhi(q.z), bflo(q.w), bfhi(q.w)};
        float s = 0.f;
#pragma unroll
        for (int e = 0; e < 8; ++e) s += y[e];
        const float mu = wave_sum(s) * (1.0f / 512.0f); float s2 = 0.f;
#pragma unroll
        for (int e = 0; e < 8; ++e) { y[e] -= mu; s2 += y[e] * y[e]; }
        const float rstd = 1.0f / sqrtf(wave_sum(s2) * (1.0f / 512.0f) + NORM_EPS);
        bf16* ap = AR + (size_t)t * 2560 + 512 + h * 512 + lane * 8; const v4u gq = *(const v4u*)ap;
        v4u o; o.x = pk2(bflo(gq.x) * y[0] * rstd, bfhi(gq.x) * y[1] * rstd); o.y = pk2(bflo(gq.y) * y[2] * rstd, bfhi(gq.y) * y[3] * rstd);
        o.z = pk2(bflo(gq.z) * y[4] * rstd, bfhi(gq.z) * y[5] * rstd); o.w = pk2(bflo(gq.w) * y[6] * rstd, bfhi(gq.w) * y[7] * rstd);
        *(v4u*)ap = o; }
}


typedef short bf16x8 __attribute__((ext_vector_type(8)));
typedef short s16x4 __attribute__((ext_vector_type(4)));
#ifdef EMU
#define TR16(p) emu_ds_read_tr16_b64((const void*)(p))
#else
typedef short v4i16_t __attribute__((ext_vector_type(4)));
#define TR16(p) __builtin_amdgcn_ds_read_tr16_b64_v4i16((LAS v4i16_t*)(p))
#endif
#define MFMA16(a, b, c) __builtin_amdgcn_mfma_f32_16x16x32_bf16((a), (b), (c), 0, 0, 0)
__device__ __forceinline__ bf16x8 cat44(const s16x4 a, const s16x4 b) { return (bf16x8){a[0], a[1], a[2], a[3], b[0], b[1], b[2], b[3]}; }
__device__ __forceinline__ bf16x8 pack8f(const f32x4 a, const f32x4 b) { const pg8::u32x4 w = pg8::pack8(a, b); return __builtin_bit_cast(bf16x8, w); }

constexpr int ATT_KS = 272, ATT_VS = 288, ATT_VOFF = 256 * ATT_KS;
static_assert(ATT_VOFF + 256 * ATT_VS <= RING_BYTES, "attention LDS");
__device__ __forceinline__ void att_unit_mfma(Frame& F, int u) {
    bf16* AQ = (bf16*)(F.ws + WS_ACT + A_AQ); const bf16* AK = (const bf16*)(F.ws + WS_ACT + A_AK); const bf16* AV = (const bf16*)(F.ws + WS_ACT + A_AV); float* LSE = (float*)(F.ws + WS_LSE);
    const int b = u / (12 * NBLK), rem = u % (12 * NBLK), gi = rem / (4 * NBLK), rem2 = rem % (4 * NBLK), j = rem2 / NBLK, blk = rem2 % NBLK;
    const int r = gi == 0 ? 1 : (gi == 1 ? 4 : 16), nb = NBLK / r, p = blk / nb, n = blk % nb, head = gi * 4 + j;
    LAS unsigned char* lds = F.lds;
    for (int idx = F.tid; idx < 256 * 16; idx += NWAVES * 64) {
        const int m = idx >> 4, ch = idx & 15; const int ti = 128 * (n - 1) + m;
        v4u kv = {0u, 0u, 0u, 0u}, vv = {0u, 0u, 0u, 0u};
        if (ti >= 0) { const size_t off = ((size_t)b * SEQ + p + (size_t)r * ti) * 1536 + head * 128 + ch * 8; kv = *(const v4u*)(AK + off); vv = *(const v4u*)(AV + off); }
        *(LAS v4u*)(lds + m * ATT_KS + ch * 16) = kv;
        *(LAS v4u*)(lds + ATT_VOFF + m * ATT_VS + ch * 16) = vv;
    }
    const int lane = F.lane, fr = lane & 15, g = lane >> 4, c0 = F.wave * 16;
    const size_t tokq = (size_t)b * SEQ + p + (size_t)r * (128 * n + c0 + fr);
    bf16* qrow = AQ + tokq * 1536 + head * 128;
    bf16x8 qf[4];
#pragma unroll
    for (int ks = 0; ks < 4; ++ks) qf[ks] = *(const bf16x8*)(qrow + 32 * ks + 8 * g);
    __syncthreads();
    f32x4 st[9];
#pragma unroll
    for (int kt = 0; kt < 9; ++kt) { st[kt] = (f32x4){0.f, 0.f, 0.f, 0.f};
#pragma unroll
        for (int ks = 0; ks < 4; ++ks) { const bf16x8 a = *(const LAS bf16x8*)(lds + (c0 + 16 * kt + fr) * ATT_KS + (32 * ks + 8 * g) * 2); st[kt] = MFMA16(a, qf[ks], st[kt]); } }
    float mx = -3.0e38f;
#pragma unroll
    for (int kt = 0; kt < 9; ++kt)
#pragma unroll
        for (int e = 0; e < 4; ++e) { const int rel = 16 * kt + 4 * g + e - fr; const bool valid = (rel >= 0) && (rel <= 128) && (n > 0 || c0 + 16 * kt + 4 * g + e >= 128);
            st[kt][e] = valid ? st[kt][e] : -3.0e38f; mx = fmaxf(mx, st[kt][e]); }
    mx = fmaxf(mx, __shfl_xor(mx, 16)); mx = fmaxf(mx, __shfl_xor(mx, 32));
    float sum = 0.f;
#pragma unroll
    for (int kt = 0; kt < 9; ++kt)
#pragma unroll
        for (int e = 0; e < 4; ++e) { const float pe = st[kt][e] > -1.0e38f ? __expf(st[kt][e] - mx) : 0.f; st[kt][e] = pe; sum += pe; }
    sum += __shfl_xor(sum, 16); sum += __shfl_xor(sum, 32);
    bf16x8 pb[5];
#pragma unroll
    for (int s2 = 0; s2 < 4; ++s2) pb[s2] = pack8f(st[2 * s2], st[2 * s2 + 1]);
    pb[4] = pack8f(st[8], (f32x4){0.f, 0.f, 0.f, 0.f});
    const int q4 = (lane & 15) >> 2, pp = lane & 3;
    const float inv = 1.0f / sum;
#pragma unroll
    for (int dt = 0; dt < 8; ++dt) { f32x4 o = {0.f, 0.f, 0.f, 0.f};
#pragma unroll
        for (int s2 = 0; s2 < 5; ++s2) { int r1 = c0 + 32 * s2 + 4 * g + q4, r2 = r1 + 16; r1 = r1 > 255 ? 255 : r1; r2 = r2 > 255 ? 255 : r2;
            const s16x4 t1 = TR16(lds + ATT_VOFF + r1 * ATT_VS + (16 * dt + 4 * pp) * 2), t2 = TR16(lds + ATT_VOFF + r2 * ATT_VS + (16 * dt + 4 * pp) * 2);
            o = MFMA16(cat44(t1, t2), pb[s2], o); }
        v2u w; w.x = pg8::cvt_pk_bf16(o[0] * inv, o[1] * inv); w.y = pg8::cvt_pk_bf16(o[2] * inv, o[3] * inv);
        *(v2u*)(qrow + 16 * dt + 4 * g) = w; }
    if (g == 0) LSE[((size_t)gi * M + tokq) * 4 + j] = mx + __logf(sum);
    __syncthreads();
}

constexpr int R_KS = 528, R_VS = 288, R_PS = 144, RL_K = 0, RL_Q = 64 * R_KS, RL_V = 2 * 64 * R_KS, RL_P = RL_V + 64 * R_VS, RL_END = RL_P + 64 * R_PS;
static_assert(RL_END <= RING_BYTES, "retention LDS");
template <bool PASS2>
__device__ __forceinline__ void ret_unit_mfma(Frame& F, int ur) {
    const bf16* RQ = (const bf16*)(F.ws + WS_ACT + A_RQ); const bf16* RK = (const bf16*)(F.ws + WS_ACT + A_RK); bf16* RV = (bf16*)(F.ws + WS_ACT + A_RV); float* FS = (float*)(F.ws + WS_ACT + A_F);
    const int g = ur % NSEG, s = (ur / NSEG) & 3, h = (ur / (NSEG * 4)) & 3, b = ur / (NSEG * 16);
    const float lg = logf(1.0f - exp2f(-5.0f - (float)h)), a64 = expf(64.0f * lg);
    LAS unsigned char* lds = F.lds;
    const int tid = F.tid, lane = F.lane, w = F.wave, fr = lane & 15, gq = lane >> 4, q4 = (lane & 15) >> 2, pp = lane & 3;
    f32x4 R[16];
#pragma unroll
    for (int T = 0; T < 16; ++T) R[T] = (f32x4){0.f, 0.f, 0.f, 0.f};
    if (PASS2) {
        for (int gp = 0; gp < g; ++gp) { const float wgt = expf((float)(1024 * (g - 1 - gp)) * lg); const float* fi = FS + ((size_t)(ur - g + gp) * 8 + w) * 4096 + lane;
#pragma unroll
            for (int T = 0; T < 16; ++T)
#pragma unroll
                for (int e = 0; e < 4; ++e) R[T][e] += wgt * fi[(T * 4 + e) * 64]; }
        for (int i = tid; i < 64 * R_PS / 16; i += NWAVES * 64) *(LAS v4u*)(lds + RL_P + i * 16) = (v4u){0u, 0u, 0u, 0u};
    }
    v4u kreg[4], qreg[4], vreg[2];
    const size_t tb0 = (size_t)b * SEQ + (size_t)g * 1024;
#define RET_ISSUE(tb) do { _Pragma("unroll") for (int jj = 0; jj < 4; ++jj) { const int idx = tid + 512 * jj, row = idx >> 5, ch = idx & 31; \
            kreg[jj] = *(const v4u*)(RK + ((tb) + row) * 1024 + h * 256 + ch * 8); if (PASS2) qreg[jj] = *(const v4u*)(RQ + ((tb) + row) * 1024 + h * 256 + ch * 8); } \
        _Pragma("unroll") for (int jj = 0; jj < 2; ++jj) { const int idx = tid + 512 * jj, row = idx >> 4, ch = idx & 15; vreg[jj] = *(const v4u*)(RV + ((tb) + row) * 2048 + h * 512 + s * 128 + ch * 8); } } while (0)
    RET_ISSUE(tb0);
    for (int i = 0; i < 16; ++i) {
        const size_t tb = tb0 + (size_t)i * 64;
#pragma unroll
        for (int jj = 0; jj < 4; ++jj) { const int idx = tid + 512 * jj, row = idx >> 5, ch = idx & 31; *(LAS v4u*)(lds + RL_K + row * R_KS + ch * 16) = kreg[jj]; if (PASS2) *(LAS v4u*)(lds + RL_Q + row * R_KS + ch * 16) = qreg[jj]; }
#pragma unroll
        for (int jj = 0; jj < 2; ++jj) { const int idx = tid + 512 * jj, row = idx >> 4, ch = idx & 15; const float z = expf((float)(63 - row) * lg); const v4u v = vreg[jj]; v4u o;
            o.x = pk2(bflo(v.x) * z, bfhi(v.x) * z); o.y = pk2(bflo(v.y) * z, bfhi(v.y) * z); o.z = pk2(bflo(v.z) * z, bfhi(v.z) * z); o.w = pk2(bflo(v.w) * z, bfhi(v.w) * z);
            *(LAS v4u*)(lds + RL_V + row * R_VS + ch * 16) = o; }
        __syncthreads();
        if (i + 1 < 16) RET_ISSUE(tb + 64);
        bf16x8 vf[2];
#pragma unroll
        for (int ks = 0; ks < 2; ++ks) { const LAS unsigned char* vp = lds + RL_V + (32 * ks + 4 * gq + q4) * R_VS + (16 * w + 4 * pp) * 2; vf[ks] = cat44(TR16(vp), TR16(vp + 16 * R_VS)); }
        if (PASS2) {
            for (int pi = w; pi < 10; pi += 8) { const int ct = (pi >= 1) + (pi >= 3) + (pi >= 6), kt = pi - ct * (ct + 1) / 2;
                f32x4 st = {0.f, 0.f, 0.f, 0.f};
#pragma unroll
                for (int ks = 0; ks < 8; ++ks) { const bf16x8 a = *(const LAS bf16x8*)(lds + RL_K + (16 * kt + fr) * R_KS + (32 * ks + 8 * gq) * 2), bq = *(const LAS bf16x8*)(lds + RL_Q + (16 * ct + fr) * R_KS + (32 * ks + 8 * gq) * 2);
                    st = MFMA16(a, bq, st); }
                const int c = 16 * ct + fr; const float dc = expf((float)(c - 63) * lg);
#pragma unroll
                for (int e = 0; e < 4; ++e) st[e] = (16 * kt + 4 * gq + e <= c) ? st[e] * dc : 0.f;
                v2u pw; pw.x = pg8::cvt_pk_bf16(st[0], st[1]); pw.y = pg8::cvt_pk_bf16(st[2], st[3]);
                *(LAS v2u*)(lds + RL_P + c * R_PS + (16 * kt + 4 * gq) * 2) = pw; }
            __syncthreads();
            f32x4 Y[4];
#pragma unroll
            for (int ct = 0; ct < 4; ++ct) Y[ct] = (f32x4){0.f, 0.f, 0.f, 0.f};
#pragma unroll
            for (int ks = 0; ks < 8; ++ks) { const bf16x8 ra = pack8f(R[2 * ks], R[2 * ks + 1]);
#pragma unroll
                for (int ct = 0; ct < 4; ++ct) { const LAS unsigned char* qp = lds + RL_Q + (16 * ct + fr) * R_KS + (32 * ks + 4 * gq) * 2;
                    const bf16x8 qb = cat44(*(const LAS s16x4*)qp, *(const LAS s16x4*)(qp + 32)); Y[ct] = MFMA16(ra, qb, Y[ct]); } }
#pragma unroll
            for (int ct = 0; ct < 4; ++ct) { const float xi = expf((float)(16 * ct + fr + 1) * lg); Y[ct] = Y[ct] * xi; }
#pragma unroll
            for (int ct = 0; ct < 4; ++ct)
#pragma unroll
                for (int ks = 0; ks <= (ct >> 1); ++ks) { const LAS unsigned char* ppz = lds + RL_P + (16 * ct + fr) * R_PS + (32 * ks + 4 * gq) * 2;
                    const bf16x8 pbq = cat44(*(const LAS s16x4*)ppz, *(const LAS s16x4*)(ppz + 32)); Y[ct] = MFMA16(vf[ks], pbq, Y[ct]); }
#pragma unroll
            for (int ct = 0; ct < 4; ++ct) { v2u yw; yw.x = pg8::cvt_pk_bf16(Y[ct][0], Y[ct][1]); yw.y = pg8::cvt_pk_bf16(Y[ct][2], Y[ct][3]);
                *(v2u*)(RV + (tb + 16 * ct + fr) * 2048 + h * 512 + s * 128 + 16 * w + 4 * gq) = yw; }
        }
#pragma unroll
        for (int T = 0; T < 16; ++T) R[T] = R[T] * a64;
#pragma unroll
        for (int ks = 0; ks < 2; ++ks)
#pragma unroll
            for (int T = 0; T < 16; ++T) { const LAS unsigned char* kp = lds + RL_K + (32 * ks + 4 * gq + q4) * R_KS + (16 * T + 4 * pp) * 2;
                R[T] = MFMA16(cat44(TR16(kp), TR16(kp + 16 * R_KS)), vf[ks], R[T]); }
        __syncthreads();
    }
#undef RET_ISSUE
    if (!PASS2) { float* fo = FS + ((size_t)ur * 8 + w) * 4096 + lane;
#pragma unroll
        for (int T = 0; T < 16; ++T)
#pragma unroll
            for (int e = 0; e < 4; ++e) fo[(T * 4 + e) * 64] = R[T][e]; }
}

#ifdef USE_SCALAR_ATT
#define ATT_UNIT att_unit_scalar
#else
#define ATT_UNIT att_unit_mfma
#endif
#ifdef USE_SCALAR_RET
#define RET_PASS1 ret_pass1_scalar
#define RET_PASS2 ret_pass2_scalar
#else
#define RET_PASS1 ret_unit_mfma<false>
#define RET_PASS2 ret_unit_mfma<true>
#endif
constexpr int N_PHASES = 1 + 14 * DEPTH;
struct Args { const float* in[12]; float* out; unsigned char* ws; int ph_lo, ph_hi, li, pad; };
__global__ void __launch_bounds__(NWAVES * 64, 2) mk_fwd(Args args) {
#ifdef EMU
    unsigned char* lds = EMU_LDS_PTR;
#else
    extern __shared__ __attribute__((aligned(16))) unsigned char lds[];
#endif
    Frame F;
    F.lds = (LAS unsigned char*)lds;
    F.MISC = (volatile LAS unsigned*)(F.lds + MISC_OFF);
    F.tid = threadIdx.x; F.lane = F.tid & 63; F.wave = __builtin_amdgcn_readfirstlane(F.tid >> 6);
    F.G = gridDim.x; { const int bx = blockIdx.x; F.vcu = (F.G % 8 == 0) ? (bx % 8) * (F.G / 8) + bx / 8 : bx; }
    F.ws = args.ws; F.ctl = (gu32*)(args.ws + WS_CTL);
    for (int u = F.tid; u < (LDS_BYTES - LDSCTL_OFF) / 4; u += NWAVES * 64) ((LAS unsigned*)(F.lds + LDSCTL_OFF))[u] = 0u;
    __syncthreads();
    const bool one_launch = (MK_N_LAUNCHES == 1);
    XcdBarrier bar; bar.bar = (unsigned*)(F.ctl + CW_BAR); bar.x = 0; bar.st = nullptr;
    if (one_launch) bar = xcd_barrier_post((unsigned*)(F.ctl + CW_BAR), F.MISC + 8);
    const int lo = args.ph_lo, hi = args.ph_hi;
    unsigned char* act = F.ws + WS_ACT;
    bf16* XN = (bf16*)(F.ws + WS_XN);
    const bf16* WinT = (const bf16*)(F.ws + WS_WIN); const bf16* WmT = (const bf16*)(F.ws + WS_WM); const bf16* WoT = (const bf16*)(F.ws + WS_WO); const bf16* WguT = (const bf16*)(F.ws + WS_WGU); const bf16* WdT = (const bf16*)(F.ws + WS_WD);

#ifndef DIS
#define DIS 0
#endif
#define PH(k) (lo <= (k) && (k) < hi)
#define EN(k) (!((DIS >> (k)) & 1))
#ifdef EMU
#define REFRESH() ((void)0)
#else
#define REFRESH() do { int t_ = threadIdx.x; asm volatile("" : "+v"(t_)); F.tid = t_; F.lane = t_ & 63; F.wave = __builtin_amdgcn_readfirstlane(t_ >> 6); \
    unsigned char* w_ = args.ws; asm volatile("" : "+s"(w_)); F.ws = w_; F.ctl = (gu32*)(w_ + WS_CTL); act = w_ + WS_ACT; XN = (bf16*)(w_ + WS_XN); \
    WinT = (const bf16*)(w_ + WS_WIN); WmT = (const bf16*)(w_ + WS_WM); WoT = (const bf16*)(w_ + WS_WO); WguT = (const bf16*)(w_ + WS_WGU); WdT = (const bf16*)(w_ + WS_WD); } while (0)
#endif
#define SEAM(k) do { if (one_launch && PH(k) && PH((k) + 1)) xcd_barrier(bar); } while (0)
    if (PH(0)) { REFRESH(); if (EN(14)) p0_weights(F, args.in, 0); p0_tables(F); p_norm_rows(F, args.in[0], args.in[8], XN); }
    SEAM(0);
#pragma unroll
    for (int l = 0; l < DEPTH; ++l) {
        const int pb = 1 + 14 * l;
        if (PH(pb + 0) && EN(0)) { REFRESH(); { pg8::Gemm g{XN, WinT, M, NATT, D, D, D}; pg8::StaticOrder S; S.init(M, NATT, F.G, (int)blockIdx.x);
            pg8::EpiAtt E{(bf16*)(act + A_AQ), (A_AK - A_AQ) / 2, (const float*)(F.ws + WS_TABA)};
            pg8::gemm_phase<pg8::EpiAtt, pg8::StaticOrder, true, true>(F.lds + RING_OFF, g, S, E); }
        }
        SEAM(pb + 0);
        if (PH(pb + 1) && EN(1)) { REFRESH(); { for (int u = F.vcu; u < NAU; u += F.G) ATT_UNIT(F, u); }
        }
        SEAM(pb + 1);
        if (PH(pb + 2) && EN(2)) { REFRESH(); p_att_merge(F);
        }
        SEAM(pb + 2);
        if (PH(pb + 3) && EN(3)) { REFRESH(); { pg8::Gemm g{XN, WinT + (size_t)NATT * D, M, NRET, D, D, D}; pg8::StaticOrder S; S.init(M, NRET, F.G, (int)blockIdx.x);
            pg8::EpiRet E{(bf16*)act, (const float*)(F.ws + WS_TABR)};
            pg8::gemm_phase<pg8::EpiRet, pg8::StaticOrder, true, true>(F.lds + RING_OFF, g, S, E); }
        }
        SEAM(pb + 3);
        if (PH(pb + 4) && EN(4)) { REFRESH(); { for (int u = F.vcu; u < NRU; u += F.G) RET_PASS1(F, u); }
        }
        SEAM(pb + 4);
        if (PH(pb + 5) && EN(5)) { REFRESH(); { for (int u = F.vcu; u < NRU; u += F.G) RET_PASS2(F, u); }
        }
        SEAM(pb + 5);
        if (PH(pb + 6) && EN(6)) { REFRESH(); p_ret_finalize(F);
        }
        SEAM(pb + 6);
        if (PH(pb + 7) && EN(7)) { REFRESH(); { pg8::Gemm g{(const bf16*)(act + A_AR), WmT, M, D, 512, 2560, 2560}; pg8::StaticOrder S; S.init(M, D, F.G, (int)blockIdx.x);
            pg8::EpiGate E{(float*)(act + A_T), nullptr, D, (const bf16*)(act + A_GA), D, nullptr, 0};
            pg8::gemm_phase<pg8::EpiGate, pg8::StaticOrder, true, true>(F.lds + RING_OFF, g, S, E); }
        }
        SEAM(pb + 7);
        if (PH(pb + 8) && EN(8)) { REFRESH(); { pg8::Gemm g{(const bf16*)(act + A_AR) + 512, WmT + 512, M, D, 2048, 2560, 2560}; pg8::StaticOrder S; S.init(M, D, F.G, (int)blockIdx.x);
            pg8::EpiGate E{nullptr, (bf16*)(act + A_MG), D, (const bf16*)(act + A_GR), D, (const float*)(act + A_T), D};
            pg8::gemm_phase<pg8::EpiGate, pg8::StaticOrder, true, true>(F.lds + RING_OFF, g, S, E); }
        }
        SEAM(pb + 8);
        if (PH(pb + 9) && EN(9)) { REFRESH(); { pg8::Gemm g{(const bf16*)(act + A_MG), WoT, M, D, D, D, D}; pg8::StaticOrder S; S.init(M, D, F.G, (int)blockIdx.x);
            pg8::EpiGate E{(float*)(act + A_M32), nullptr, D, nullptr, 0, nullptr, 0};
            pg8::gemm_phase<pg8::EpiGate, pg8::StaticOrder, true, true>(F.lds + RING_OFF, g, S, E); }
        }
        SEAM(pb + 9);
        if (PH(pb + 10) && EN(10)) { REFRESH(); p_resid_rows(F, (const float*)(act + A_M32), l == 0 ? args.in[0] : args.out, args.out, args.in[9] + (size_t)l * D, args.in[10] + (size_t)l * D, XN);
        }
        SEAM(pb + 10);
        if (PH(pb + 11) && EN(11)) { REFRESH(); { pg8::Gemm g{XN, WguT, M, 2 * DFF, D, D, D}; pg8::StaticOrder S; S.init(M, 2 * DFF, F.G, (int)blockIdx.x);
            pg8::EpiSwiGLU E{(bf16*)(act + A_ACT), DFF};
            pg8::gemm_phase<pg8::EpiSwiGLU, pg8::StaticOrder, true, true>(F.lds + RING_OFF, g, S, E); }
        }
        SEAM(pb + 11);
        if (PH(pb + 12) && EN(12)) { REFRESH(); { pg8::Gemm g{(const bf16*)(act + A_ACT), WdT, M, D, DFF, DFF, DFF}; pg8::StaticOrder S; S.init(M, D, F.G, (int)blockIdx.x);
            pg8::EpiGate E{(float*)(act + A_F32), nullptr, D, nullptr, 0, nullptr, 0};
            pg8::gemm_phase<pg8::EpiGate, pg8::StaticOrder, true, true>(F.lds + RING_OFF, g, S, E); }
        }
        SEAM(pb + 12);
        if (PH(pb + 13) && EN(13)) { REFRESH(); { const bool more = (l + 1 < DEPTH);
            p_resid_rows(F, (const float*)(act + A_F32), args.out, args.out, args.in[11] + (size_t)l * D, more ? args.in[8] + (size_t)(l + 1) * D : nullptr, XN);
            if (more) p0_weights(F, args.in, l + 1); }
        }
        SEAM(pb + 13);
    }
}

extern "C" void kernel_launch(void* const* d_in, const int* in_sizes, int n_in, void* d_out, int out_size, void* d_ws, size_t ws_size, hipStream_t stream) {
    static int grid = 0;
    if (grid == 0) {
        if (n_in != 12 || in_sizes[0] != M * D || out_size != M * D || ws_size < WS_END) { fprintf(stderr, "kernel_launch: unexpected shapes (n_in %d, in0 %d, out %d, ws %zu need %zu); nothing launched\n", n_in, n_in > 0 ? in_sizes[0] : -1, out_size, ws_size, (size_t)WS_END); grid = -1; return; }
        int dev = 0, cus = 0, per_cu = 0;
        if (hipGetDevice(&dev) != hipSuccess || hipDeviceGetAttribute(&cus, hipDeviceAttributeMultiprocessorCount, dev) != hipSuccess) { grid = -1; return; }
        if (hipFuncSetAttribute((const void*)mk_fwd, hipFuncAttributeMaxDynamicSharedMemorySize, LDS_BYTES) != hipSuccess) { fprintf(stderr, "kernel_launch: hipFuncSetAttribute failed\n"); grid = -1; return; }
        if (hipOccupancyMaxActiveBlocksPerMultiprocessor(&per_cu, (const void*)mk_fwd, NWAVES * 64, LDS_BYTES) != hipSuccess || per_cu < 1) fprintf(stderr, "kernel_launch: occupancy query reports %d\n", per_cu);
        (void)hipGetLastError();
        grid = cus;
    }
    if (grid < 0) return;
    if (hipMemsetAsync((char*)d_ws + WS_CTL, 0, CTL_ZERO_BYTES, stream) != hipSuccess) return;
    Args a{};
    for (int i = 0; i < 12; ++i) a.in[i] = (const float*)d_in[i];
    a.out = (float*)d_out; a.ws = (unsigned char*)d_ws;
    if (MK_N_LAUNCHES == 1) { a.ph_lo = 0; a.ph_hi = N_PHASES; a.li = 0; hipLaunchKernelGGL(mk_fwd, dim3(grid), dim3(NWAVES * 64), LDS_BYTES, stream, a); }
    else for (int ph = 0; ph < N_PHASES; ++ph) { a.ph_lo = ph; a.ph_hi = ph + 1; a.li = ph; hipLaunchKernelGGL(mk_fwd, dim3(grid), dim3(NWAVES * 64), LDS_BYTES, stream, a); }
}
```
